# Optimizing an MI355X kernel written in HIP

```python
import math
import jax
import jax.numpy as jnp
from jax import lax
import numpy as np

D_MODEL = 1024
BATCH = 8
SEQ = 2048
DEPTH = 2

HEAD_DIM = 64
GRID_W = 64
N_MEM = 256
A_HEADS = 8
A_WIDTH = A_HEADS * HEAD_DIM
A_GROUPS = ((128, 1), (512, 4), (2048, 16))
BAND_BLOCK = 64
B_HEADS = 8
B_WIDTH = B_HEADS * HEAD_DIM
B_DECAY_LORA = 64
B_ICLR_LORA = 64
B_GN_EPS = 64e-5
B_MIX_COLS = 3 * B_WIDTH + 2 * B_DECAY_LORA + 2 * B_ICLR_LORA
C_HEADS = 8
C_KV_HEADS = 2
C_REP = C_HEADS // C_KV_HEADS
C_WIDTH = C_HEADS * HEAD_DIM
C_KV_WIDTH = C_KV_HEADS * HEAD_DIM
ROPE_THETA = 10000.0
D_HEADS = 4
D_VDIM = 2 * HEAD_DIM
D_QK_WIDTH = D_HEADS * 2 * HEAD_DIM
D_V_WIDTH = D_HEADS * D_VDIM
M_HEADS = 4
M_WIDTH = M_HEADS * HEAD_DIM
NUM_BUCKETS = 32
REL_MAX_DISTANCE = 1024
QBLK = 128
N_BRANCHES = 5

A_SPLIT = (A_WIDTH, A_WIDTH, A_WIDTH, A_WIDTH)
B_SPLIT = (B_WIDTH, B_WIDTH, B_WIDTH, 2 * B_DECAY_LORA, 2 * B_ICLR_LORA, B_WIDTH)
C_SPLIT = (C_WIDTH, C_KV_WIDTH, C_KV_WIDTH, C_WIDTH)
D_SPLIT = (D_QK_WIDTH, D_QK_WIDTH, D_V_WIDTH, D_V_WIDTH)
M_SPLIT = (M_WIDTH, M_WIDTH)
BRANCH_WIDTHS = (A_WIDTH, B_WIDTH, C_WIDTH, D_V_WIDTH, M_WIDTH)

F32 = jnp.float32
NEG_INF = -1e30

kernel_name = 'hybrid_gated_parallel_encoder'


def split_last(t, sizes):
    parts, start = [], 0
    for size in sizes:
        parts.append(t[..., start:start + size])
        start += size
    return parts


def to_heads(t, n_heads):
    b, s, _ = t.shape
    return t.reshape(b, s, n_heads, -1).transpose(0, 2, 1, 3)


def from_heads(t):
    b, h, s, d = t.shape
    return t.transpose(0, 2, 1, 3).reshape(b, s, h * d)


def layer_norm(t, g, b, eps=1e-5):
    tf = t.astype(F32)
    mu = jnp.mean(tf, -1, keepdims=True)
    var = jnp.mean(jnp.square(tf - mu), -1, keepdims=True)
    return ((tf - mu) * lax.rsqrt(var + eps) * g + b).astype(t.dtype)


def rms_norm(t, g, eps=1e-6):
    tf = t.astype(F32)
    return (tf * lax.rsqrt(jnp.mean(jnp.square(tf), -1, keepdims=True) + eps) * g).astype(t.dtype)


def rel_bucket(rel):
    nb = NUM_BUCKETS // 2
    max_exact = nb // 2
    n = jnp.abs(rel)
    nf = jnp.maximum(n, 1).astype(F32)
    large = max_exact + (jnp.log(nf / max_exact) / math.log(REL_MAX_DISTANCE / max_exact)
                         * (nb - max_exact)).astype(jnp.int32)
    large = jnp.minimum(large, nb - 1)
    return jnp.where(rel > 0, nb, 0) + jnp.where(n < max_exact, n, large)


def dilated_branch(q, k, v, table, window, dil):
    b, h, s, d = q.shape
    radius = window // (2 * dil)
    L = s // dil
    nblk = -(-L // BAND_BLOCK)
    lp = nblk * BAND_BLOCK
    kw = BAND_BLOCK + 2 * radius

    def strided(t):
        return t.reshape(b, h, L, dil, d).swapaxes(2, 3)

    qs = jnp.pad(strided(q), ((0, 0), (0, 0), (0, 0), (0, lp - L), (0, 0)))
    kpad = ((0, 0), (0, 0), (0, 0), (radius, radius + lp - L), (0, 0))
    ks = jnp.pad(strided(k), kpad)
    vs = jnp.pad(strided(v), kpad)
    qb = qs.reshape(b, h, dil, nblk, BAND_BLOCK, d)
    idx = (jnp.arange(nblk) * BAND_BLOCK)[:, None] + jnp.arange(kw)[None, :]
    kb = ks[:, :, :, idx]
    vb = vs[:, :, :, idx]
    off = jnp.arange(kw)[None, :] - radius - jnp.arange(BAND_BLOCK)[:, None]
    bias = jnp.moveaxis(table[rel_bucket(off * dil)], -1, 0).astype(F32)
    kpos = idx - radius
    valid = (jnp.abs(off) <= radius)[None] & ((kpos >= 0) & (kpos < L))[:, None, :]
    logits = jnp.einsum('bhrnqd,bhrnkd->bhrnqk', qb, kb).astype(F32) * (d ** -0.5) + bias[:, None, None]
    logits = jnp.where(valid, logits, NEG_INF)
    m = jnp.max(logits, -1, keepdims=True)
    e = jnp.exp(logits - m)
    den = jnp.sum(e, -1, keepdims=True)
    o = jnp.einsum('bhrnqk,bhrnkd->bhrnqd', e, vb.astype(F32)) / den
    lse = (m + jnp.log(den))[..., 0]
    o = o.reshape(b, h, dil, lp, d)[:, :, :, :L].swapaxes(2, 3).reshape(b, h, s, d)
    lse = lse.reshape(b, h, dil, lp)[..., :L].swapaxes(2, 3).reshape(b, h, s)
    return o, lse


def mixer_dilated(pa, table_a):
    q, k, v, g = split_last(pa, A_SPLIT)
    q, k, v = (to_heads(t, A_HEADS) for t in (q, k, v))
    outs, lses = [], []
    for window, dil in A_GROUPS:
        o, lse = dilated_branch(q, k, v, table_a, window, dil)
        outs.append(o)
        lses.append(lse)
    wts = jax.nn.softmax(jnp.stack(lses), axis=0)
    o = jnp.sum(wts[..., None] * jnp.stack(outs), axis=0)
    return from_heads(o).astype(pa.dtype) * jax.nn.silu(g)


def rwkv7_step(state, inp):
    r, w, k, v, a, bb = inp
    sa = jnp.einsum('bhij,bhj->bhi', state, a)
    state = state * w[:, :, None, :] + sa[..., None] * bb[:, :, None, :] + v[..., None] * k[:, :, None, :]
    return state, jnp.einsum('bhij,bhj->bhi', state, r)


def mixer_rwkv(pb, mu, w0, w_up, a0, a_up, k_k, k_a, r_k, ln_g, ln_b):
    b, s, _ = pb.shape
    xm, g = pb[..., :B_MIX_COLS], pb[..., B_MIX_COLS:]
    prev = jnp.pad(xm[:, :-1], ((0, 0), (1, 0), (0, 0)))
    nxt = jnp.pad(xm[:, 1:], ((0, 0), (0, 1), (0, 0)))
    xm = xm + mu[0] * (prev - xm) + mu[1] * (nxt - xm)
    r, k, v, wd, ad = (t.astype(F32) for t in split_last(xm, B_SPLIT[:5]))
    wd = wd.reshape(b, s, 2, B_DECAY_LORA)
    ad = ad.reshape(b, s, 2, B_ICLR_LORA)
    w_log = -jax.nn.softplus(-(w0 + jnp.einsum('bser,erc->bsec', jnp.tanh(wd), w_up))) - 0.5
    decay = jnp.exp(-jnp.exp(w_log.astype(F32)))
    a = jax.nn.sigmoid((a0 + jnp.einsum('bser,erc->bsec', ad, a_up)).astype(F32))
    kk = (k * k_k).reshape(b, s, B_HEADS, HEAD_DIM)
    kk = (kk / jnp.maximum(jnp.linalg.norm(kk, axis=-1, keepdims=True), 1e-12)).reshape(b, s, B_WIDTH)

    def seq_heads(t):
        return t.reshape(b, s, B_HEADS, HEAD_DIM).transpose(1, 0, 2, 3)

    rh, vh, ah = seq_heads(r), seq_heads(v), seq_heads(-kk)
    ys, bonuses = [], []
    for e, rev in ((0, False), (1, True)):
        ke = k * (1.0 + (a[:, :, e] - 1.0) * k_a)
        be = kk * a[:, :, e]
        xs = (rh, seq_heads(decay[:, :, e]), seq_heads(ke), vh, ah, seq_heads(be))
        _, ye = lax.scan(rwkv7_step, jnp.zeros((b, B_HEADS, HEAD_DIM, HEAD_DIM), F32), xs, reverse=rev)
        ys.append(ye)
        bonuses.append(jnp.sum((r * ke * r_k.reshape(-1)).reshape(b, s, B_HEADS, HEAD_DIM), -1, keepdims=True))
    y = (ys[0] + ys[1]).transpose(1, 0, 2, 3)
    mu_y = jnp.mean(y, -1, keepdims=True)
    var_y = jnp.mean(jnp.square(y - mu_y), -1, keepdims=True)
    gn = ((y - mu_y) * lax.rsqrt(var_y + B_GN_EPS)).reshape(b, s, B_WIDTH) * ln_g + ln_b
    bonus = ((bonuses[0] + bonuses[1]) * v.reshape(b, s, B_HEADS, HEAD_DIM)).reshape(b, s, B_WIDTH)
    return (gn + bonus).astype(pb.dtype) * jax.nn.silu(g)


def axial_rope(t, row, col):
    d = t.shape[-1]
    half = d // 2
    qtr = half // 2
    freqs = ROPE_THETA ** (-(jnp.arange(qtr, dtype=F32) / qtr))

    def rot(u, pos):
        ang = pos.astype(F32)[:, None] * freqs[None, :]
        c, sn = jnp.cos(ang), jnp.sin(ang)
        u1, u2 = u[..., :qtr], u[..., qtr:]
        return jnp.concatenate([u1 * c - u2 * sn, u1 * sn + u2 * c], -1)

    tf = t.astype(F32)
    return jnp.concatenate([rot(tf[..., :half], row), rot(tf[..., half:], col)], -1).astype(t.dtype)


def mixer_axial_gqa(pc, qn_g, kn_g, row, col):
    b, s, _ = pc.shape
    q, k, v, g = split_last(pc, C_SPLIT)
    q = axial_rope(rms_norm(q.reshape(b, s, C_HEADS, HEAD_DIM), qn_g).transpose(0, 2, 1, 3), row, col)
    k = axial_rope(rms_norm(k.reshape(b, s, C_KV_HEADS, HEAD_DIM), kn_g).transpose(0, 2, 1, 3), row, col)
    v = to_heads(v, C_KV_HEADS)
    q = q.reshape(b, C_KV_HEADS, C_REP, s, HEAD_DIM)
    scale = HEAD_DIM ** -0.5

    def block(i):
        qb = lax.dynamic_slice_in_dim(q, i * QBLK, QBLK, axis=3)
        p = jax.nn.softmax(jnp.einsum('bgrqd,bgkd->bgrqk', qb, k).astype(F32) * scale, axis=-1)
        return jnp.einsum('bgrqk,bgkd->bgrqd', p, v.astype(F32))

    o = lax.map(block, jnp.arange(s // QBLK))
    o = jnp.moveaxis(o, 0, 3).reshape(b, C_HEADS, s, HEAD_DIM)
    return from_heads(o).astype(pc.dtype) * jax.nn.silu(g)


def mixer_diff(pd, lam_params, subln_g, table_d, layer_idx):
    b, s, _ = pd.shape
    q, k, v, g = split_last(pd, D_SPLIT)
    q = q.reshape(b, s, D_HEADS, 2, HEAD_DIM).transpose(3, 0, 2, 1, 4)
    k = k.reshape(b, s, D_HEADS, 2, HEAD_DIM).transpose(3, 0, 2, 1, 4)
    v = to_heads(v, D_HEADS).astype(F32)
    lam_init = 0.8 - 0.6 * math.exp(-0.3 * layer_idx)
    lq1, lk1, lq2, lk2 = lam_params[0], lam_params[1], lam_params[2], lam_params[3]
    lam = (jnp.exp(jnp.sum(lq1 * lk1)) - jnp.exp(jnp.sum(lq2 * lk2)) + lam_init).astype(F32)
    scale = HEAD_DIM ** -0.5
    kpos = jnp.arange(s)

    def block(i):
        start = i * QBLK
        qb = lax.dynamic_slice_in_dim(q, start, QBLK, axis=3)
        rel = kpos[None, :] - (start + jnp.arange(QBLK))[:, None]
        bias = jnp.moveaxis(table_d[rel_bucket(rel)], -1, 0).astype(F32)
        p = jax.nn.softmax(jnp.einsum('cbhqd,cbhkd->cbhqk', qb, k).astype(F32) * scale + bias, axis=-1)
        return jnp.einsum('bhqk,bhkd->bhqd', p[0] - lam * p[1], v)

    o = lax.map(block, jnp.arange(s // QBLK))
    o = jnp.moveaxis(o, 0, 2).reshape(b, D_HEADS, s, D_VDIM)
    o = rms_norm(o, subln_g, eps=1e-5) * (1.0 - lam_init)
    return from_heads(o).astype(pd.dtype) * jax.nn.silu(g)


def mixer_memory(pm, mem, w_mem_kv):
    q, g = split_last(pm, M_SPLIT)
    q = to_heads(q, M_HEADS)
    km, vm = split_last(jnp.einsum('bmd,dc->bmc', mem, w_mem_kv), (M_WIDTH, M_WIDTH))
    km, vm = to_heads(km, M_HEADS), to_heads(vm, M_HEADS)
    p = jax.nn.softmax(jnp.einsum('bhqd,bhmd->bhqm', q, km).astype(F32) * (HEAD_DIM ** -0.5), axis=-1)
    o = jnp.einsum('bhqm,bhmd->bhqd', p, vm.astype(F32))
    return from_heads(o).astype(pm.dtype) * jax.nn.silu(g)


def gated_merge(h, branch_outs, w_branch, w_gate, b_gate):
    d = h.shape[-1]
    terms, start = [], 0
    for i, (o, wdt) in enumerate(zip(branch_outs, BRANCH_WIDTHS)):
        proj = jnp.einsum('bsc,cd->bsd', o, w_branch[start:start + wdt])
        gate = jax.nn.sigmoid(jnp.einsum('bsd,de->bse', h, w_gate[:, i * d:(i + 1) * d]) + b_gate[i * d:(i + 1) * d])
        terms.append(gate * proj)
        start += wdt
    return sum(terms[1:], terms[0])


def setup_inputs(seed: int = 0) -> dict:
    key = jax.random.key(seed)
    ks = jax.random.split(key, 28)
    d = D_MODEL
    in_cols = sum(A_SPLIT) + sum(B_SPLIT) + sum(C_SPLIT) + sum(D_SPLIT) + sum(M_SPLIT)
    beta = (8 * DEPTH) ** -0.25

    def nrm(k, shape, scale):
        return scale * jax.random.normal(k, shape, F32)

    w_branch = jnp.concatenate(
        [nrm(jax.random.fold_in(ks[21], i), (DEPTH, wdt, d), beta * wdt ** -0.5)
         for i, wdt in enumerate(BRANCH_WIDTHS)], axis=1)
    return {
        'x': nrm(ks[0], (BATCH, SEQ, d), 1.0),
        'mem': nrm(ks[1], (BATCH, N_MEM, d), 1.0),
        'ln_in_g': 1.0 + nrm(ks[2], (d,), 0.02),
        'ln_in_b': nrm(ks[3], (d,), 0.02),
        'rel_bias': nrm(ks[4], (NUM_BUCKETS, A_HEADS + D_HEADS), 0.5),
        'w_in': nrm(ks[5], (DEPTH, d, in_cols), d ** -0.5),
        'shift_mu': jax.random.uniform(ks[6], (DEPTH, 2, B_MIX_COLS), F32, 0.0, 0.5),
        'rwkv_w0': jax.random.uniform(ks[7], (DEPTH, 2, B_WIDTH), F32, -6.5, -1.0),
        'rwkv_w_up': nrm(ks[8], (DEPTH, 2, B_DECAY_LORA, B_WIDTH), 0.1),
        'rwkv_a0': nrm(ks[9], (DEPTH, 2, B_WIDTH), 0.1),
        'rwkv_a_up': nrm(ks[10], (DEPTH, 2, B_ICLR_LORA, B_WIDTH), 0.5 * B_ICLR_LORA ** -0.5),
        'rwkv_k_k': 0.85 + nrm(ks[11], (DEPTH, B_WIDTH), 0.05),
        'rwkv_k_a': 1.0 + nrm(ks[12], (DEPTH, B_WIDTH), 0.05),
        'rwkv_r_k': nrm(ks[13], (DEPTH, B_HEADS, HEAD_DIM), 0.1),
        'rwkv_ln_g': 1.0 + nrm(ks[14], (DEPTH, B_WIDTH), 0.02),
        'rwkv_ln_b': nrm(ks[15], (DEPTH, B_WIDTH), 0.02),
        'c_qnorm_g': 1.0 + nrm(ks[16], (DEPTH, HEAD_DIM), 0.02),
        'c_knorm_g': 1.0 + nrm(ks[17], (DEPTH, HEAD_DIM), 0.02),
        'd_lambda': nrm(ks[18], (DEPTH, 4, HEAD_DIM), 0.1),
        'd_subln_g': 1.0 + nrm(ks[19], (DEPTH, D_VDIM), 0.02),
        'w_mem_kv': nrm(ks[20], (DEPTH, d, 2 * M_WIDTH), d ** -0.5),
        'w_branch': w_branch,
        'w_gate': nrm(ks[22], (DEPTH, d, N_BRANCHES * d), d ** -0.5),
        'b_gate': nrm(ks[23], (DEPTH, N_BRANCHES * d), 0.1),
        'w_out': nrm(ks[24], (DEPTH, d, d), beta * d ** -0.5),
        'ln_g': 1.0 + nrm(ks[25], (DEPTH, d), 0.02),
        'ln_b': nrm(ks[26], (DEPTH, d), 0.02),
    }


def reference(x, mem, ln_in_g, ln_in_b, rel_bias, w_in, shift_mu, rwkv_w0, rwkv_w_up, rwkv_a0,
              rwkv_a_up, rwkv_k_k, rwkv_k_a, rwkv_r_k, rwkv_ln_g, rwkv_ln_b, c_qnorm_g, c_knorm_g,
              d_lambda, d_subln_g, w_mem_kv, w_branch, w_gate, b_gate, w_out, ln_g, ln_b):
    s = x.shape[1]
    rows = s // GRID_W
    row = jnp.repeat(jnp.arange(rows, dtype=jnp.int32), GRID_W)
    col = jnp.tile(jnp.arange(GRID_W, dtype=jnp.int32), rows)
    table_a = rel_bias[:, :A_HEADS]
    table_d = rel_bias[:, A_HEADS:]
    alpha = (2 * DEPTH) ** 0.25
    mixer_sizes = (sum(A_SPLIT), sum(B_SPLIT), sum(C_SPLIT), sum(D_SPLIT), sum(M_SPLIT))
    h = layer_norm(x, ln_in_g, ln_in_b)
    for l in range(DEPTH):
        p = jnp.einsum('bsd,dc->bsc', h, w_in[l])
        pa, pb, pc, pd, pm = split_last(p, mixer_sizes)
        o_a = mixer_dilated(pa, table_a)
        o_b = mixer_rwkv(pb, shift_mu[l], rwkv_w0[l], rwkv_w_up[l], rwkv_a0[l], rwkv_a_up[l],
                         rwkv_k_k[l], rwkv_k_a[l], rwkv_r_k[l], rwkv_ln_g[l], rwkv_ln_b[l])
        o_c = mixer_axial_gqa(pc, c_qnorm_g[l], c_knorm_g[l], row, col)
        o_d = mixer_diff(pd, d_lambda[l], d_subln_g[l], table_d, l)
        o_m = mixer_memory(pm, mem, w_mem_kv[l])
        y = gated_merge(h, (o_a, o_b, o_c, o_d, o_m), w_branch[l], w_gate[l], b_gate[l])
        out = jnp.einsum('bsd,de->bse', y, w_out[l])
        h = layer_norm(alpha * h + out, ln_g[l], ln_b[l])
    return h
```

```cpp
#include <hip/hip_runtime.h>
#include <hip/hip_cooperative_groups.h>
#include <stdint.h>
#include <stdio.h>
namespace cg = cooperative_groups;

#ifndef MEGA
#define MEGA 1
#endif
#ifndef DUP_PHASE
#define DUP_PHASE 0
#endif

#define DEVI __device__ __forceinline__
typedef unsigned short bf16_t;
typedef short bf16x8 __attribute__((ext_vector_type(8)));
typedef float f32x4 __attribute__((ext_vector_type(4)));
typedef float f32x2 __attribute__((ext_vector_type(2)));
typedef unsigned u32x4 __attribute__((ext_vector_type(4)));
typedef unsigned u32x2 __attribute__((ext_vector_type(2)));
typedef __bf16 bf16x2_t __attribute__((ext_vector_type(2)));

constexpr int S = 2048, DM = 1024, NBATCH = 8, T_ALL = NBATCH * S;
constexpr int NB = 4, TC = NB * S, NCHUNK = NBATCH / NB;
constexpr int PC = 8192;
constexpr int A_Q = 0, A_K = 512, A_V = 1024, A_G = 1536;
constexpr int B_R = 2048, B_K = 2560, B_V = 3072, B_WD = 3584, B_AD = 3712, B_G = 3840;
constexpr int C_Q = 4352, C_K = 4864, C_V = 4992, C_G = 5120;
constexpr int D_Q = 5632, D_K = 6144, D_V = 6656, D_G = 7168;
constexpr int M_Q = 7680, M_G = 7936;
constexpr int NMEM = 256;
constexpr float LOG2E = 1.4426950408889634f;
constexpr float NEGBIG = -1e30f;
constexpr int LDS_CTRL = 73728;
constexpr int LDS_BYTES_C = LDS_CTRL + 64;

constexpr size_t MiB = 1u << 20;
constexpr size_t WS_CTL = 0;
constexpr size_t WS_TAB = 1 * MiB;
constexpr size_t WS_WIN = 2 * MiB;
constexpr size_t WS_WGATE = 18 * MiB;
constexpr size_t WS_WBR = 28 * MiB;
constexpr size_t WS_WOUT = 32 * MiB + 512 * 1024;
constexpr size_t WS_WMEM = 36 * MiB + 512 * 1024;
constexpr size_t WS_MEMB = 38 * MiB + 512 * 1024;
constexpr size_t WS_MEMKV = 42 * MiB + 512 * 1024;
constexpr size_t WS_HB = 46 * MiB + 512 * 1024;
constexpr size_t WS_P = 78 * MiB + 512 * 1024;
constexpr size_t WS_AT = 206 * MiB + 512 * 1024;
constexpr size_t WS_LSE = 230 * MiB + 512 * 1024;
constexpr size_t WS_YS = 231 * MiB + 256 * 1024;
constexpr size_t WS_BON = 247 * MiB + 256 * 1024;
constexpr size_t WS_STATS = 248 * MiB;
constexpr size_t WS_BONP = 250 * MiB;
constexpr size_t WS_END = 252 * MiB;
constexpr int TB_COS = 0, TB_SIN = 1024, TB_BD = 2048  , TB_BA = 2048 + 16384  , TB_LAM = 2048 + 16384 + 6144  , TB_BA2 = 24640  ;

struct Params {
  const float* in[27];
  float* out;
  unsigned char* ws;
};

#define LAUNDER_S(x) asm volatile("" : "+s"(x))
#define GAS __attribute__((address_space(1)))
#define LAUNDER_GP(x) do { size_t o_ = 0; asm volatile("" : "+s"(o_)); x += o_; } while (0)
#define LAUNDER_V(x) asm volatile("" : "+v"(x))
DEVI unsigned pk2(float lo, float hi) { f32x2 v = {lo, hi}; return __builtin_bit_cast(unsigned, __builtin_convertvector(v, bf16x2_t)); }
DEVI float bflo(unsigned u) { return __uint_as_float(u << 16); }
DEVI float bfhi(unsigned u) { return __uint_as_float(u & 0xffff0000u); }
DEVI float bf1(bf16_t b) { return __uint_as_float(((unsigned)b) << 16); }
DEVI float rcp_f(float x) { return __builtin_amdgcn_rcpf(x); }
DEVI float silu_f(float x) { return x * rcp_f(1.f + __expf(-x)); }
DEVI float sigmoid_f(float x) { return rcp_f(1.f + __expf(-x)); }
DEVI float wave_sum(float v) {
#pragma unroll
  for (int o = 1; o < 64; o <<= 1) v += __shfl_xor(v, o);
  return v;
}
DEVI float row16_sum(float v) {
  v += __int_as_float(__builtin_amdgcn_update_dpp(0, __float_as_int(v), 0x128, 0xf, 0xf, false));
  v += __int_as_float(__builtin_amdgcn_update_dpp(0, __float_as_int(v), 0x124, 0xf, 0xf, false));
  v += __int_as_float(__builtin_amdgcn_update_dpp(0, __float_as_int(v), 0x122, 0xf, 0xf, false));
  v += __int_as_float(__builtin_amdgcn_update_dpp(0, __float_as_int(v), 0x121, 0xf, 0xf, false));
  return v;
}
#define ATTN_WAIT_BARRIER(N) do { asm volatile("s_waitcnt vmcnt(" #N ")" ::: "memory"); asm volatile("s_waitcnt lgkmcnt(0)" ::: "memory"); __builtin_amdgcn_s_barrier(); } while (0)
DEVI f32x4 mfma16(bf16x8 a, bf16x8 b, f32x4 c) { return __builtin_amdgcn_mfma_f32_16x16x32_bf16(a, b, c, 0, 0, 0); }

DEVI int rel_bucket(int rel) {
  int n = rel < 0 ? -rel : rel;
  int b;
  if (n < 8) b = n; else if (n < 15) b = 8; else if (n < 27) b = 9; else if (n < 50) b = 10; else if (n < 91) b = 11;
  else if (n < 166) b = 12; else if (n < 305) b = 13; else if (n < 559) b = 14; else b = 15;
  return (rel > 0 ? 16 : 0) + b;
}

DEVI void tconv_tile(const float* __restrict__ src, int K, int N, bf16_t* __restrict__ dst, int ldd, int tile, float* lds) {
  int tid = threadIdx.x; LAUNDER_V(tid);
  const int ntn = N >> 6, tk = tile / ntn, tn = tile - tk * ntn, k0 = tk * 64, n0 = tn * 64;
  {
    const int cx = tid & 63, ry = tid >> 6;
#pragma unroll
    for (int i = 0; i < 16; ++i) { const int k = 4 * i + ry; lds[k * 65 + cx] = src[(size_t)(k0 + k) * N + n0 + cx]; }
  }
  __syncthreads();
  {
    const int kx = tid & 7, ny = tid >> 3;
#pragma unroll
    for (int i = 0; i < 2; ++i) {
      const int n = ny + 32 * i; const float* s = lds + (8 * kx) * 65 + n;
      u32x4 o; o.x = pk2(s[0], s[65]); o.y = pk2(s[130], s[195]); o.z = pk2(s[260], s[325]); o.w = pk2(s[390], s[455]);
      *(u32x4*)(dst + (size_t)(n0 + n) * ldd + k0 + 8 * kx) = o;
    }
  }
  __syncthreads();
}

DEVI void convert_layer_weights(const Params& p, int l, int first, int stride, float* lds, int last = 16 * 128 + 16 * 80 + 36 * 16 + 16 * 16) {
  unsigned char* ws = p.ws;
  const float* w_in = p.in[5] + (size_t)l * 1024 * 8192;
  const float* w_gate = p.in[22] + (size_t)l * 1024 * 5120;
  const float* w_br = p.in[21] + (size_t)l * 2304 * 1024;
  const float* w_out = p.in[24] + (size_t)l * 1024 * 1024;
  constexpr int T_IN = 16 * 128, T_G = 16 * 80, T_B = 36 * 16, T_O = 16 * 16;
  for (int it = first; it < last; it += stride) {
    int r = it;
    if (r < T_IN) { tconv_tile(w_in, 1024, 8192, (bf16_t*)(ws + WS_WIN), 1024, r, lds); continue; } r -= T_IN;
    if (r < T_G) { tconv_tile(w_gate, 1024, 5120, (bf16_t*)(ws + WS_WGATE), 1024, r, lds); continue; } r -= T_G;
    if (r < T_B) { tconv_tile(w_br, 2304, 1024, (bf16_t*)(ws + WS_WBR), 2304, r, lds); continue; } r -= T_B;
    tconv_tile(w_out, 1024, 1024, (bf16_t*)(ws + WS_WOUT) + (size_t)l * 1024 * 1024, 1024, r, lds);
  }
}

DEVI void phase_setup(const Params& p, char* ldsc) {
  float* lds = (float*)ldsc;
  unsigned char* ws = p.ws;
  LAUNDER_GP(ws);
  int tid = threadIdx.x; LAUNDER_V(tid);
  const int lane = tid & 63, wave = tid >> 6, G = gridDim.x, bid = blockIdx.x;
  convert_layer_weights(p, 0, bid, G, lds);
  for (int it = bid; it < 2 * 128; it += G) {
    const int l = it >> 7;
    tconv_tile(p.in[20] + (size_t)l * 1024 * 512, 1024, 512, (bf16_t*)(ws + WS_WMEM) + (size_t)l * 512 * 1024, 1024, it & 127, lds);
  }
  {
    const float* x = p.in[0]; const float* g = p.in[2]; const float* b = p.in[3];
    bf16_t* hb = (bf16_t*)(ws + WS_HB);
    for (int row = bid * 4 + wave; row < T_ALL; row += G * 4) {
      const f32x4* xr = (const f32x4*)(x + (size_t)row * DM) + lane;
      f32x4 v[4]; float s = 0.f;
#pragma unroll
      for (int j = 0; j < 4; ++j) { v[j] = xr[64 * j]; s += (v[j].x + v[j].y) + (v[j].z + v[j].w); }
      const float mean = wave_sum(s) * (1.f / DM); float s2 = 0.f;
#pragma unroll
      for (int j = 0; j < 4; ++j) { v[j] = v[j] - mean; s2 += (v[j].x * v[j].x + v[j].y * v[j].y) + (v[j].z * v[j].z + v[j].w * v[j].w); }
      const float rstd = rsqrtf(wave_sum(s2) * (1.f / DM) + 1e-5f);
#pragma unroll
      for (int j = 0; j < 4; ++j) {
        const f32x4 gg = ((const f32x4*)g)[lane + 64 * j], bb = ((const f32x4*)b)[lane + 64 * j];
        f32x4 o = v[j] * rstd * gg + bb;
        ((f32x4*)(p.out + (size_t)row * DM))[lane + 64 * j] = o;
        u32x2 w; w.x = pk2(o.x, o.y); w.y = pk2(o.z, o.w);
        ((u32x2*)(hb + (size_t)row * DM))[lane + 64 * j] = w;
      }
    }
  }
  {
    const float* mem = p.in[1]; bf16_t* mb = (bf16_t*)(ws + WS_MEMB);
    for (int i = bid * 256 + tid; i < NBATCH * NMEM * DM / 8; i += G * 256) {
      const f32x4 a = ((const f32x4*)mem)[2 * i], b = ((const f32x4*)mem)[2 * i + 1];
      u32x4 o; o.x = pk2(a.x, a.y); o.y = pk2(a.z, a.w); o.z = pk2(b.x, b.y); o.w = pk2(b.z, b.w);
      ((u32x4*)mb)[i] = o;
    }
  }
  {
    float* tab = (float*)(ws + WS_TAB);
    const float* rel_bias = p.in[4];
    const int gt = bid * 256 + tid, GT = G * 256;
    for (int i = gt; i < 1024; i += GT) {
      const int pos = i >> 4, c = i & 15;
      const float freq = powf(10000.f, -(float)c / 16.f);
      const float ang = (float)pos * freq;
      tab[TB_COS + i] = cosf(ang); tab[TB_SIN + i] = sinf(ang);
    }
    for (int i = gt; i < 4 * 4096; i += GT) {
      const int h = i >> 12, idx = i & 4095, rel = idx - 2047;
      tab[TB_BD + i] = (idx < 4095) ? rel_bias[rel_bucket(rel) * 12 + 8 + h] * LOG2E : 0.f;
    }
    for (int i = gt; i < 3 * 8 * 256; i += GT) {
      const int gi = i >> 11, h = (i >> 8) & 7, idx = i & 255, off = idx - 128;
      const int dil = gi == 0 ? 1 : (gi == 1 ? 4 : 16);
      const bool ok = off >= -64 && off <= 64;
      tab[TB_BA + i] = ok ? rel_bias[rel_bucket(off * dil) * 12 + h] * LOG2E : NEGBIG;
    }
    for (int i = gt; i < 3 * 8 * 384; i += GT) {
      const int gi = i / 3072, rem = i - gi * 3072, h = rem / 384, idx = rem - h * 384, off = idx - 192;
      const int dil = gi == 0 ? 1 : (gi == 1 ? 4 : 16);
      const bool ok = off >= -64 && off <= 64;
      tab[TB_BA2 + i] = ok ? rel_bias[rel_bucket(off * dil) * 12 + h] * LOG2E : 2.f * NEGBIG;
    }
    if (gt < 2) {
      const float* dl = p.in[18] + (size_t)gt * 256;
      float s1 = 0.f, s2 = 0.f;
      for (int j = 0; j < 64; ++j) { s1 += dl[j] * dl[64 + j]; s2 += dl[128 + j] * dl[192 + j]; }
      const float lam_init = 0.8f - 0.6f * expf(-0.3f * (float)gt);
      tab[TB_LAM + gt] = expf(s1) - expf(s2) + lam_init;
    }
  }
}

template <bool LOWREG = false>
DEVI void gemm_core(const bf16_t* __restrict__ Ag, int lda, const bf16_t* __restrict__ Bg, int ldb, int nk, f32x4 (&acc)[4][4], char* lds) {
  int tid = threadIdx.x;
  asm volatile("" : "+v"(tid));
  const int lane = tid & 63, wave = tid >> 6, wm = wave >> 1, wn = wave & 1;
  char* As = lds; char* Bs = lds + 32768;
  const int srow = 8 * wave + (lane >> 3), sch = (lane & 7) ^ (lane >> 3);
  const bf16_t* ap = Ag + (size_t)srow * lda + sch * 8;
  const bf16_t* bp = Bg + (size_t)srow * ldb + sch * 8;
#pragma unroll
  for (int i = 0; i < 4; ++i) {
    __builtin_amdgcn_global_load_lds((const unsigned*)(ap + (size_t)(32 * i) * lda), (unsigned*)(As + (4 * i + wave) * 1024), 16, 0, 0);
    __builtin_amdgcn_global_load_lds((const unsigned*)(bp + (size_t)(32 * i) * ldb), (unsigned*)(Bs + (4 * i + wave) * 1024), 16, 0, 0);
  }
  asm volatile("s_waitcnt vmcnt(0)" ::: "memory");
  __syncthreads();
  const int frow = (lane & 15) * 128, fg = lane >> 4, fx = lane & 7;
  for (int kt = 0; kt < nk; ++kt) {
    const int cur = kt & 1;
    if (kt + 1 < nk) {
      ap += 64; bp += 64;
      char* Aw = As + (cur ^ 1) * 16384; char* Bw = Bs + (cur ^ 1) * 16384;
#pragma unroll
      for (int i = 0; i < 4; ++i) {
        __builtin_amdgcn_global_load_lds((const unsigned*)(ap + (size_t)(32 * i) * lda), (unsigned*)(Aw + (4 * i + wave) * 1024), 16, 0, 0);
        __builtin_amdgcn_global_load_lds((const unsigned*)(bp + (size_t)(32 * i) * ldb), (unsigned*)(Bw + (4 * i + wave) * 1024), 16, 0, 0);
      }
    }
    const char* Ab = As + cur * 16384 + wm * 8192 + frow;
    const char* Bb = Bs + cur * 16384 + wn * 8192 + frow;
#pragma unroll
    for (int ks = 0; ks < 2; ++ks) {
      const int co = ((4 * ks + fg) ^ fx) << 4;
      bf16x8 af[4], bf[4];
#pragma unroll
      for (int i = 0; i < 4; ++i) { af[i] = *(const bf16x8*)(Ab + i * 2048 + co); bf[i] = *(const bf16x8*)(Bb + i * 2048 + co); }
#pragma unroll
      for (int j = 0; j < 4; ++j)
#pragma unroll
        for (int i = 0; i < 4; ++i) acc[j][i] = mfma16(bf[j], af[i], acc[j][i]);
      if (LOWREG) __builtin_amdgcn_sched_barrier(0);
    }
    asm volatile("s_waitcnt vmcnt(0)" ::: "memory");
    __syncthreads();
  }
}

DEVI void zero_acc(f32x4 (&acc)[4][4]) {
#pragma unroll
  for (int j = 0; j < 4; ++j)
#pragma unroll
    for (int i = 0; i < 4; ++i) acc[j][i] = (f32x4){0.f, 0.f, 0.f, 0.f};
}

DEVI void gemm_core_256(const bf16_t* __restrict__ Ag, int lda, const bf16_t* __restrict__ Bg, int ldb, int nk, f32x4 (&acc)[4][8], char* lds) {
  int tid = threadIdx.x;
  asm volatile("" : "+v"(tid));
  const int lane = tid & 63, wave = tid >> 6, wm = wave >> 1, wn = wave & 1;
  char* As = lds; char* Bs = lds + 49152;
  const int srow = lane >> 2, sch = (lane & 3) ^ ((lane >> 3) & 3);
  const bf16_t* ap = Ag + (size_t)(16 * wave + srow) * lda + sch * 8;
  const bf16_t* bp = Bg + (size_t)(16 * wave + srow) * ldb + sch * 8;
#pragma unroll
  for (int st = 0; st < 2; ++st) {
#pragma unroll
    for (int i = 0; i < 4; ++i) __builtin_amdgcn_global_load_lds((const unsigned*)(ap + (size_t)(64 * i) * lda), (unsigned*)(As + st * 16384 + (4 * i + wave) * 1024), 16, 0, 0);
#pragma unroll
    for (int i = 0; i < 2; ++i) __builtin_amdgcn_global_load_lds((const unsigned*)(bp + (size_t)(64 * i) * ldb), (unsigned*)(Bs + st * 8192 + (4 * i + wave) * 1024), 16, 0, 0);
    ap += 32; bp += 32;
  }
  ATTN_WAIT_BARRIER(6);
  const int q = lane & 15, g = lane >> 4;
  const int foff = q * 64 + ((g ^ ((q >> 1) & 3)) << 4);
  int slot = 0;
  for (int kt = 0; kt < nk; ++kt) {
    if (kt + 2 < nk) {
      int ns = slot + 2; if (ns >= 3) ns -= 3;
      char* Aw = As + ns * 16384; char* Bw = Bs + ns * 8192;
#pragma unroll
      for (int i = 0; i < 4; ++i) __builtin_amdgcn_global_load_lds((const unsigned*)(ap + (size_t)(64 * i) * lda), (unsigned*)(Aw + (4 * i + wave) * 1024), 16, 0, 0);
#pragma unroll
      for (int i = 0; i < 2; ++i) __builtin_amdgcn_global_load_lds((const unsigned*)(bp + (size_t)(64 * i) * ldb), (unsigned*)(Bw + (4 * i + wave) * 1024), 16, 0, 0);
      ap += 32; bp += 32;
    }
    const char* Ab = As + slot * 16384 + wm * 8192 + foff;
    const char* Bb = Bs + slot * 8192 + wn * 4096 + foff;
    bf16x8 bf[4];
#pragma unroll
    for (int j = 0; j < 4; ++j) bf[j] = *(const bf16x8*)(Bb + j * 1024);
#pragma unroll
    for (int i = 0; i < 8; ++i) {
      const bf16x8 af = *(const bf16x8*)(Ab + i * 1024);
#pragma unroll
      for (int j = 0; j < 4; ++j) acc[j][i] = mfma16(bf[j], af, acc[j][i]);
    }
    if (kt + 2 < nk) ATTN_WAIT_BARRIER(6); else ATTN_WAIT_BARRIER(0);
    ++slot; if (slot >= 3) slot = 0;
  }
}

template <int MODE>
DEVI void gemm_core_probe(const bf16_t* __restrict__ Ag, int lda, const bf16_t* __restrict__ Bg, int ldb, int nk, f32x4 (&acc)[4][4], char* lds) {
  int tid = threadIdx.x;
  asm volatile("" : "+v"(tid));
  const int lane = tid & 63, wave = tid >> 6, wm = wave >> 1, wn = wave & 1;
  char* As = lds; char* Bs = lds + 32768;
  const int srow = 8 * wave + (lane >> 3), sch = (lane & 7) ^ (lane >> 3);
  const bf16_t* ap = Ag + (size_t)srow * lda + sch * 8;
  const bf16_t* bp = Bg + (size_t)srow * ldb + sch * 8;
#pragma unroll
  for (int i = 0; i < 4; ++i) {
    __builtin_amdgcn_global_load_lds((const unsigned*)(ap + (size_t)(32 * i) * lda), (unsigned*)(As + (4 * i + wave) * 1024), 16, 0, 0);
    __builtin_amdgcn_global_load_lds((const unsigned*)(bp + (size_t)(32 * i) * ldb), (unsigned*)(Bs + (4 * i + wave) * 1024), 16, 0, 0);
  }
  asm volatile("s_waitcnt vmcnt(0)" ::: "memory");
  __syncthreads();
  const int frow = (lane & 15) * 128, fg = lane >> 4, fx = lane & 7;
  for (int kt = 0; kt < nk; ++kt) {
    const int cur = kt & 1;
    if (kt + 1 < nk && MODE != 1) {
      ap += 64; bp += 64;
      char* Aw = As + (cur ^ 1) * 16384; char* Bw = Bs + (cur ^ 1) * 16384;
#pragma unroll
      for (int i = 0; i < 4; ++i) {
        __builtin_amdgcn_global_load_lds((const unsigned*)(ap + (size_t)(32 * i) * lda), (unsigned*)(Aw + (4 * i + wave) * 1024), 16, 0, 0);
        __builtin_amdgcn_global_load_lds((const unsigned*)(bp + (size_t)(32 * i) * ldb), (unsigned*)(Bw + (4 * i + wave) * 1024), 16, 0, 0);
      }
    }
    const char* Ab = As + cur * 16384 + wm * 8192 + frow;
    const char* Bb = Bs + cur * 16384 + wn * 8192 + frow;
#pragma unroll
    for (int ks = 0; ks < (MODE == 2 ? 0 : 2); ++ks) {
      const int co = ((4 * ks + fg) ^ fx) << 4;
      bf16x8 af[4], bf[4];
#pragma unroll
      for (int i = 0; i < 4; ++i) { af[i] = *(const bf16x8*)(Ab + i * 2048 + co); bf[i] = *(const bf16x8*)(Bb + i * 2048 + co); }
#pragma unroll
      for (int j = 0; j < 4; ++j)
#pragma unroll
        for (int i = 0; i < 4; ++i) acc[j][i] = mfma16(bf[j], af[i], acc[j][i]);

    }
    asm volatile("s_waitcnt vmcnt(0)" ::: "memory");
    __syncthreads();
  }
}


template <int MODE>
DEVI void p_tile_probe(const Params& p, int l, int c, int mp, int np, char* lds) {
  unsigned char* ws = p.ws;
  LAUNDER_GP(ws);
  const bf16_t* HB = (const bf16_t*)(ws + WS_HB) + (size_t)c * TC * DM;
  const bf16_t* WIN = (const bf16_t*)(ws + WS_WIN);
  f32x4 acc[4][4]; zero_acc(acc);
  gemm_core_probe<MODE>(HB + (size_t)(mp * 128) * DM, DM, WIN + (size_t)(np * 128) * DM, DM, 16, acc, lds);
#pragma unroll
  for (int j = 0; j < 4; ++j)
#pragma unroll
    for (int i = 0; i < 4; ++i) asm volatile("" :: "v"(acc[j][i]));
}
DEVI void ln_apply_rows(const struct Params& p, int l, int c, int first, int stride, int last = TC / 4);
DEVI void p_tile(const Params& p, int l, int c, int mp, int np, char* lds) {
  unsigned char* ws = p.ws;
  LAUNDER_GP(ws);
  int t2_ = threadIdx.x; LAUNDER_V(t2_);
  const int lane = t2_ & 63, wave = t2_ >> 6, wm = wave >> 1, wn = wave & 1, q = lane & 15, g = lane >> 4;
  const bf16_t* HB = (const bf16_t*)(ws + WS_HB) + (size_t)c * TC * DM;
  const bf16_t* WIN = (const bf16_t*)(ws + WS_WIN);
  bf16_t* P = (bf16_t*)(ws + WS_P);
  const float* tab = (const float*)(ws + WS_TAB);
  const int m0 = mp * 128, n0 = np * 128;
  f32x4 acc[4][4]; zero_acc(acc);
  gemm_core(HB + (size_t)m0 * DM, DM, WIN + (size_t)n0 * DM, DM, 16, acc, lds);
  const int ncol0 = n0 + wn * 64;
  if (ncol0 >= C_Q && ncol0 < C_V) {
    const float* gain = (ncol0 < C_K ? p.in[16] : p.in[17]) + (size_t)l * 64;
    float gn[4][4];
#pragma unroll
    for (int j = 0; j < 4; ++j)
#pragma unroll
      for (int r = 0; r < 4; ++r) gn[j][r] = gain[16 * j + 4 * g + r];
#pragma unroll
    for (int i = 0; i < 4; ++i) {
      float ss = 0.f;
#pragma unroll
      for (int j = 0; j < 4; ++j)
#pragma unroll
        for (int r = 0; r < 4; ++r) ss += acc[j][i][r] * acc[j][i][r];
      ss += __shfl_xor(ss, 16); ss += __shfl_xor(ss, 32);
      const float rinv = rsqrtf(ss * (1.f / 64.f) + 1e-6f);
      const int t = (m0 + wm * 64 + 16 * i + q) & (S - 1), prow = t >> 6, pcol = t & 63;
      const f32x4 cr = *(const f32x4*)(tab + TB_COS + prow * 16 + 4 * g), sr = *(const f32x4*)(tab + TB_SIN + prow * 16 + 4 * g);
      const f32x4 cc = *(const f32x4*)(tab + TB_COS + pcol * 16 + 4 * g), sc = *(const f32x4*)(tab + TB_SIN + pcol * 16 + 4 * g);
#pragma unroll
      for (int r = 0; r < 4; ++r) {
        const float u1 = acc[0][i][r] * rinv * gn[0][r], u2 = acc[1][i][r] * rinv * gn[1][r];
        const float w1 = acc[2][i][r] * rinv * gn[2][r], w2 = acc[3][i][r] * rinv * gn[3][r];
        acc[0][i][r] = u1 * cr[r] - u2 * sr[r]; acc[1][i][r] = u1 * sr[r] + u2 * cr[r];
        acc[2][i][r] = w1 * cc[r] - w2 * sc[r]; acc[3][i][r] = w1 * sc[r] + w2 * cc[r];
      }
    }
  }
  char* wl = lds + wave * 8704;
#pragma unroll
  for (int i = 0; i < 4; ++i)
#pragma unroll
    for (int j = 0; j < 4; ++j) { u32x2 w; w.x = pk2(acc[j][i][0], acc[j][i][1]); w.y = pk2(acc[j][i][2], acc[j][i][3]); *(u32x2*)(wl + (16 * i + q) * 136 + (16 * j + 4 * g) * 2) = w; }
  bf16_t* ob = P + (size_t)(m0 + wm * 64) * PC + ncol0;
#pragma unroll
  for (int k = 0; k < 8; ++k) {
    const int idx = lane + 64 * k, row = idx >> 3, ch = idx & 7;
    const u32x2 lo = *(const u32x2*)(wl + row * 136 + ch * 16), hi = *(const u32x2*)(wl + row * 136 + ch * 16 + 8);
    *(u32x4*)(ob + (size_t)row * PC + ch * 8) = (u32x4){lo.x, lo.y, hi.x, hi.y};
  }
}
DEVI void memkv_tile(const Params& p, int e, char* lds) {
  unsigned char* ws = p.ws;
  LAUNDER_GP(ws);
  int t2_ = threadIdx.x; LAUNDER_V(t2_);
  const int lane = t2_ & 63, wave = t2_ >> 6, wm = wave >> 1, wn = wave & 1, q = lane & 15, g = lane >> 4;
  const int ll = e >> 6, mp = (e >> 2) & 15, np = e & 3;
  const int m0 = mp * 128, n0 = np * 128;
  f32x4 acc[4][4]; zero_acc(acc);
  gemm_core((const bf16_t*)(ws + WS_MEMB) + (size_t)m0 * DM, DM, (const bf16_t*)(ws + WS_WMEM) + (size_t)ll * 512 * 1024 + (size_t)n0 * DM, DM, 16, acc, lds);
  bf16_t* O = (bf16_t*)(ws + WS_MEMKV) + (size_t)ll * 2048 * 512;
#pragma unroll
  for (int i = 0; i < 4; ++i) {
    bf16_t* rowp = O + (size_t)(m0 + wm * 64 + 16 * i + q) * 512 + n0 + wn * 64 + 4 * g;
#pragma unroll
    for (int j = 0; j < 4; ++j) { u32x2 w; w.x = pk2(acc[j][i][0], acc[j][i][1]); w.y = pk2(acc[j][i][2], acc[j][i][3]); *(u32x2*)(rowp + 16 * j) = w; }
  }
}

typedef short v4i16_t __attribute__((ext_vector_type(4)));
template <int NDT>
DEVI void attn_stage(const bf16_t* Kb, size_t kstride, const bf16_t* Vb, size_t vstride, int kpos0, char* Kl, char* Vl) {
  int tid = threadIdx.x; asm volatile("" : "+v"(tid));
  const int lane = tid & 63, wave = tid >> 6;
#pragma unroll
  for (int i = 0; i < 2; ++i) {
    const int key = 8 * (4 * i + wave) + (lane >> 3), ch = (lane & 7) ^ (lane >> 3);
    __builtin_amdgcn_global_load_lds((const unsigned*)(Kb + (ptrdiff_t)(kpos0 + key) * (ptrdiff_t)kstride + ch * 8), (unsigned*)(Kl + (4 * i + wave) * 1024), 16, 0, 0);
  }
  if (NDT == 4) {
#pragma unroll
    for (int i = 0; i < 2; ++i) {
      const int key = 8 * (4 * i + wave) + (lane >> 3), cp = lane & 7;
      const int cl = ((((cp >> 1) ^ ((key >> 1) & 3)) << 1) | (cp & 1));
      __builtin_amdgcn_global_load_lds((const unsigned*)(Vb + (ptrdiff_t)(kpos0 + key) * (ptrdiff_t)vstride + cl * 8), (unsigned*)(Vl + (4 * i + wave) * 1024), 16, 0, 0);
    }
  } else {
#pragma unroll
    for (int i = 0; i < 4; ++i) {
      const int key = 4 * (4 * i + wave) + (lane >> 4), cp = lane & 15;
      const int cl = ((((cp >> 1) ^ (key & 7)) << 1) | (cp & 1));
      __builtin_amdgcn_global_load_lds((const unsigned*)(Vb + (ptrdiff_t)(kpos0 + key) * (ptrdiff_t)vstride + cl * 8), (unsigned*)(Vl + (4 * i + wave) * 1024), 16, 0, 0);
    }
  }
}

template <int NDT, int NQS, bool HASTAB, int RING>
DEVI void attn_pass(const bf16_t* Qb, size_t qstride, const bf16_t* Kb, size_t kstride, const bf16_t* Vb, size_t vstride,
                    int kt_lo, int kt_hi, int kbase, int qpos0, const float* tab, int tab_off, char* lds,
                    f32x4 (&o)[NDT][NQS], float (&m_run)[NQS], float (&l_run)[NQS]) {
  int tid_ = threadIdx.x; asm volatile("" : "+v"(tid_));
  const int lane = tid_ & 63, wave = tid_ >> 6, q = lane & 15, g = lane >> 4;
  const int qw = wave * 16 * NQS;
  constexpr int VB_BYTES = NDT * 2048, ROWB = NDT * 32;
  static_assert(RING == 2 || RING == 3, "ring depth");
  char* Kl = lds; char* Vl = lds + RING * 8192;
  bf16x8 qf[NQS][2];
#pragma unroll
  for (int qs = 0; qs < NQS; ++qs)
#pragma unroll
    for (int ks = 0; ks < 2; ++ks) qf[qs][ks] = *(const bf16x8*)(Qb + (size_t)(qw + 16 * qs + q) * qstride + 32 * ks + 8 * g);
#pragma unroll
  for (int dt = 0; dt < NDT; ++dt)
#pragma unroll
    for (int qs = 0; qs < NQS; ++qs) o[dt][qs] = (f32x4){0.f, 0.f, 0.f, 0.f};
#pragma unroll
  for (int qs = 0; qs < NQS; ++qs) { m_run[qs] = NEGBIG; l_run[qs] = 0.f; }
  const float sc = 0.125f * LOG2E;
  const int n = kt_hi - kt_lo;
  attn_stage<NDT>(Kb, kstride, Vb, vstride, kbase + 64 * kt_lo, Kl, Vl);
  if (RING == 3) {
    if (n > 1) { attn_stage<NDT>(Kb, kstride, Vb, vstride, kbase + 64 * (kt_lo + 1), Kl + 8192, Vl + VB_BYTES); if (NDT == 4) ATTN_WAIT_BARRIER(4); else ATTN_WAIT_BARRIER(6); }
    else ATTN_WAIT_BARRIER(0);
  } else ATTN_WAIT_BARRIER(0);
  const int frow = q * 128, fx = lane & 7;
  const int qq = q >> 2, pp = lane & 3;
  const int vrow = 4 * g + qq;
  const int vsw = (NDT == 4) ? ((vrow >> 1) & 3) : (vrow & 7);
  const int vbase = vrow * ROWB + 8 * pp;
  int slot = 0;
  for (int i = 0; i < n; ++i) {
    if (i + RING - 1 < n) {
      int ns = slot + RING - 1; if (ns >= RING) ns -= RING;
      attn_stage<NDT>(Kb, kstride, Vb, vstride, kbase + 64 * (kt_lo + i + RING - 1), Kl + ns * 8192, Vl + ns * VB_BYTES);
    }
    const int kt = kt_lo + i;
    const char* Kc = Kl + slot * 8192 + frow;
    const char* Vc = Vl + slot * VB_BYTES + vbase;
    f32x4 s[4][NQS];
#pragma unroll
    for (int k4 = 0; k4 < 4; ++k4)
#pragma unroll
      for (int qs = 0; qs < NQS; ++qs) s[k4][qs] = (f32x4){0.f, 0.f, 0.f, 0.f};
#pragma unroll
    for (int ks = 0; ks < 2; ++ks) {
      const int co = ((4 * ks + g) ^ fx) << 4;
#pragma unroll
      for (int k4 = 0; k4 < 4; ++k4) {
        const bf16x8 kf = *(const bf16x8*)(Kc + k4 * 2048 + co);
#pragma unroll
        for (int qs = 0; qs < NQS; ++qs) s[k4][qs] = mfma16(kf, qf[qs][ks], s[k4][qs]);
      }
    }
    bf16x8 pf[NQS][2];
#pragma unroll
    for (int qs = 0; qs < NQS; ++qs) {
      float tm = NEGBIG;
      if (HASTAB) {
        const float* tp = tab + (kbase + 64 * kt + 4 * g) - (qpos0 + qw + 16 * qs + q) + tab_off;
#pragma unroll
        for (int k4 = 0; k4 < 4; ++k4)
#pragma unroll
          for (int r = 0; r < 4; ++r) { const float x = s[k4][qs][r] * sc + tp[16 * k4 + r]; s[k4][qs][r] = x; tm = fmaxf(tm, x); }
      } else {
#pragma unroll
        for (int k4 = 0; k4 < 4; ++k4)
#pragma unroll
          for (int r = 0; r < 4; ++r) { const float x = s[k4][qs][r] * sc; s[k4][qs][r] = x; tm = fmaxf(tm, x); }
      }
      tm = fmaxf(tm, __shfl_xor(tm, 16)); tm = fmaxf(tm, __shfl_xor(tm, 32));
      const float mn = fmaxf(m_run[qs], tm);
      const float alpha = __builtin_amdgcn_exp2f(m_run[qs] - mn);
      m_run[qs] = mn;
      float ls = 0.f;
#pragma unroll
      for (int k4 = 0; k4 < 4; ++k4)
#pragma unroll
        for (int r = 0; r < 4; ++r) { const float pv = __builtin_amdgcn_exp2f(s[k4][qs][r] - mn); s[k4][qs][r] = pv; ls += pv; }
      l_run[qs] = l_run[qs] * alpha + ls;
      if (__builtin_amdgcn_ballot_w64(alpha != 1.f) != 0ull) {
#pragma unroll
        for (int dt = 0; dt < NDT; ++dt) o[dt][qs] = o[dt][qs] * alpha;
      }
#pragma unroll
      for (int kb = 0; kb < 2; ++kb) {
        u32x4 w;
        w.x = pk2(s[2 * kb][qs][0], s[2 * kb][qs][1]); w.y = pk2(s[2 * kb][qs][2], s[2 * kb][qs][3]);
        w.z = pk2(s[2 * kb + 1][qs][0], s[2 * kb + 1][qs][1]); w.w = pk2(s[2 * kb + 1][qs][2], s[2 * kb + 1][qs][3]);
        pf[qs][kb] = __builtin_bit_cast(bf16x8, w);
      }
    }
#pragma unroll
    for (int kb = 0; kb < 2; ++kb) {
#pragma unroll
      for (int dt = 0; dt < NDT; ++dt) {
        const char* vp = Vc + (32 * kb) * ROWB + ((dt ^ vsw) << 5);
        const v4i16_t v0 = __builtin_amdgcn_ds_read_tr16_b64_v4i16((__attribute__((address_space(3))) v4i16_t*)vp);
        const v4i16_t v1 = __builtin_amdgcn_ds_read_tr16_b64_v4i16((__attribute__((address_space(3))) v4i16_t*)(vp + 16 * ROWB));
        bf16x8 vf; vf[0] = v0[0]; vf[1] = v0[1]; vf[2] = v0[2]; vf[3] = v0[3]; vf[4] = v1[0]; vf[5] = v1[1]; vf[6] = v1[2]; vf[7] = v1[3];
#pragma unroll
        for (int qs = 0; qs < NQS; ++qs) o[dt][qs] = mfma16(vf, pf[qs][kb], o[dt][qs]);
      }
    }
    if (RING == 3 && i + 2 < n) { if (NDT == 4) ATTN_WAIT_BARRIER(4); else ATTN_WAIT_BARRIER(6); }
    else ATTN_WAIT_BARRIER(0);
    ++slot; if (slot >= RING) slot = 0;
  }
#pragma unroll
  for (int qs = 0; qs < NQS; ++qs) { float l = l_run[qs]; l += __shfl_xor(l, 16); l += __shfl_xor(l, 32); l_run[qs] = l; }
}

DEVI void attn_tile_CM(const Params& p, int l, int c, int tile, bool isM, char* lds, int dry) {
  unsigned char* ws = p.ws;
  LAUNDER_GP(ws);
  bf16_t* P = (bf16_t*)(ws + WS_P);
  int tid_ = threadIdx.x; asm volatile("" : "+v"(tid_));
  const int lane = tid_ & 63, wave = tid_ >> 6, q = lane & 15, g = lane >> 4;
  f32x4 o[4][2]; float m_run[2], l_run[2];
  int b, h, qt, gcol;
  if (!isM) {
    b = tile >> 7; h = (tile >> 4) & 7; qt = tile & 15; gcol = C_G + 64 * h;
    const bf16_t* base = P + (size_t)(b * S) * PC;
    attn_pass<4, 2, false, 3>(base + (size_t)(128 * qt) * PC + C_Q + 64 * h, PC, base + C_K + 64 * (h >> 2), PC, base + C_V + 64 * (h >> 2), PC,
                           0, 32, 0, 128 * qt, nullptr, 0, lds, o, m_run, l_run);
  } else {
    b = tile >> 6; h = (tile >> 4) & 3; qt = tile & 15; gcol = M_G + 64 * h;
    const bf16_t* base = P + (size_t)(b * S) * PC;
    const bf16_t* kv = (const bf16_t*)(ws + WS_MEMKV) + (size_t)l * 2048 * 512 + (size_t)((c * NB + b) * NMEM) * 512;
    attn_pass<4, 2, false, 3>(base + (size_t)(128 * qt) * PC + M_Q + 64 * h, PC, kv + 64 * h, 512, kv + 256 + 64 * h, 512,
                           0, 4, 0, 128 * qt, nullptr, 0, lds, o, m_run, l_run);
  }
#pragma unroll
  for (int qs = 0; qs < 2; ++qs) {
    const float inv = 1.f / l_run[qs];
    bf16_t* rowp = P + (size_t)(b * S + 128 * qt + wave * 32 + 16 * qs + q) * PC + gcol + 4 * g;
#pragma unroll
    for (int dt = 0; dt < 4; ++dt) {
      const u32x2 gt = *(const u32x2*)(rowp + 16 * dt);
      u32x2 w;
      w.x = pk2(o[dt][qs][0] * inv * silu_f(bflo(gt.x)), o[dt][qs][1] * inv * silu_f(bfhi(gt.x)));
      w.y = pk2(o[dt][qs][2] * inv * silu_f(bflo(gt.y)), o[dt][qs][3] * inv * silu_f(bfhi(gt.y)));
      if (!dry) *(u32x2*)(rowp + 16 * dt) = w;
    }
  }
}

DEVI void attn_tile_D(const Params& p, int l, int c, int tile, char* lds, int dry) {
  unsigned char* ws = p.ws;
  LAUNDER_GP(ws);
  bf16_t* P = (bf16_t*)(ws + WS_P);
  const float* tabg = (const float*)(ws + WS_TAB);
  int tid = threadIdx.x; asm volatile("" : "+v"(tid));
  const int lane = tid & 63, wave = tid >> 6, q = lane & 15, g = lane >> 4;
  const int b = tile >> 7, h = (tile >> 5) & 3, qt = tile & 31;
  float* tl = (float*)(lds + 65536);
  for (int i = tid; i < 1408; i += 256) tl[i] = tabg[TB_BD + h * 4096 + (i - 703 + 2047)];
  const float bias_neg = tabg[TB_BD + h * 4096 + 2047 - 1000], bias_pos = tabg[TB_BD + h * 4096 + 2047 + 1000];
  __syncthreads();
  const bf16_t* base = P + (size_t)(b * S) * PC;
  const bf16_t* Kb = base + D_K + 128 * h;
  const bf16_t* Vb = base + D_V + 128 * h;
  const int qrow = 64 * qt + wave * 16 + q;
  const float lam = tabg[TB_LAM + l];
  const float lam_init = 0.8f - 0.6f * __expf(-0.3f * (float)l);
  bf16x8 qf[2][2];
#pragma unroll
  for (int mp = 0; mp < 2; ++mp)
#pragma unroll
    for (int ks = 0; ks < 2; ++ks) qf[mp][ks] = *(const bf16x8*)(base + (size_t)qrow * PC + D_Q + 128 * h + 64 * mp + 32 * ks + 8 * g);
  f32x4 o[2][8];
#pragma unroll
  for (int mp = 0; mp < 2; ++mp)
#pragma unroll
    for (int dt = 0; dt < 8; ++dt) o[mp][dt] = (f32x4){0.f, 0.f, 0.f, 0.f};
  float m_run[2] = {NEGBIG, NEGBIG}, l_run[2] = {0.f, 0.f};
  const float sc = 0.125f * LOG2E;
  auto stage = [&](int kt, int slot) {
    char* Kl = lds + slot * 16384; char* Vl = lds + 32768 + slot * 16384;
#pragma unroll
    for (int i = 0; i < 4; ++i) {
      const int key = 4 * (4 * i + wave) + (lane >> 4), cp = lane & 15;
      const int ck = cp ^ (key & 15);
      __builtin_amdgcn_global_load_lds((const unsigned*)(Kb + (size_t)(64 * kt + key) * PC + ck * 8), (unsigned*)(Kl + (4 * i + wave) * 1024), 16, 0, 0);
      const int cv = ((((cp >> 1) ^ (key & 7)) << 1) | (cp & 1));
      __builtin_amdgcn_global_load_lds((const unsigned*)(Vb + (size_t)(64 * kt + key) * PC + cv * 8), (unsigned*)(Vl + (4 * i + wave) * 1024), 16, 0, 0);
    }
  };
  stage(0, 0);
  ATTN_WAIT_BARRIER(0);
  const int qq = q >> 2, pp = lane & 3, vrow = 4 * g + qq, vsw = vrow & 7, vbase = vrow * 256 + 8 * pp;
  for (int kt = 0; kt < 32; ++kt) {
    const int slot = kt & 1;
    if (kt + 1 < 32) stage(kt + 1, slot ^ 1);
    const char* Kc = lds + slot * 16384 + q * 256;
    const char* Vc = lds + 32768 + slot * 16384 + vbase;
    f32x4 s[2][4];
#pragma unroll
    for (int mp = 0; mp < 2; ++mp)
#pragma unroll
      for (int k4 = 0; k4 < 4; ++k4) s[mp][k4] = (f32x4){0.f, 0.f, 0.f, 0.f};
#pragma unroll
    for (int mp = 0; mp < 2; ++mp)
#pragma unroll
      for (int ks = 0; ks < 2; ++ks) {
        const int co = ((8 * mp + 4 * ks + g) ^ q) << 4;
#pragma unroll
        for (int k4 = 0; k4 < 4; ++k4) s[mp][k4] = mfma16(*(const bf16x8*)(Kc + k4 * 4096 + co), qf[mp][ks], s[mp][k4]);
      }
    f32x4 bs[4];
    const int d0 = 64 * kt - 64 * qt;
    if (d0 - 63 >= 559 || d0 + 63 <= -559) {
      const float bc = (d0 > 0) ? bias_pos : bias_neg;
#pragma unroll
      for (int k4 = 0; k4 < 4; ++k4) bs[k4] = (f32x4){bc, bc, bc, bc};
    } else {
      const float* tp = tl + (64 * kt + 4 * g) - qrow + 703;
#pragma unroll
      for (int k4 = 0; k4 < 4; ++k4)
#pragma unroll
        for (int r = 0; r < 4; ++r) bs[k4][r] = tp[16 * k4 + r];
    }
    bf16x8 pf[2][2];
#pragma unroll
    for (int mp = 0; mp < 2; ++mp) {
      float tm = NEGBIG;
#pragma unroll
      for (int k4 = 0; k4 < 4; ++k4)
#pragma unroll
        for (int r = 0; r < 4; ++r) { const float x = s[mp][k4][r] * sc + bs[k4][r]; s[mp][k4][r] = x; tm = fmaxf(tm, x); }
      tm = fmaxf(tm, __shfl_xor(tm, 16)); tm = fmaxf(tm, __shfl_xor(tm, 32));
      const float mn = fmaxf(m_run[mp], tm);
      const float alpha = __builtin_amdgcn_exp2f(m_run[mp] - mn);
      m_run[mp] = mn;
      float ls = 0.f;
#pragma unroll
      for (int k4 = 0; k4 < 4; ++k4)
#pragma unroll
        for (int r = 0; r < 4; ++r) { const float pv = __builtin_amdgcn_exp2f(s[mp][k4][r] - mn); s[mp][k4][r] = pv; ls += pv; }
      l_run[mp] = l_run[mp] * alpha + ls;
      if (__builtin_amdgcn_ballot_w64(alpha != 1.f) != 0ull) {
#pragma unroll
        for (int dt = 0; dt < 8; ++dt) o[mp][dt] = o[mp][dt] * alpha;
      }
#pragma unroll
      for (int kb = 0; kb < 2; ++kb) {
        u32x4 w;
        w.x = pk2(s[mp][2 * kb][0], s[mp][2 * kb][1]); w.y = pk2(s[mp][2 * kb][2], s[mp][2 * kb][3]);
        w.z = pk2(s[mp][2 * kb + 1][0], s[mp][2 * kb + 1][1]); w.w = pk2(s[mp][2 * kb + 1][2], s[mp][2 * kb + 1][3]);
        pf[mp][kb] = __builtin_bit_cast(bf16x8, w);
      }
    }
#pragma unroll
    for (int kb = 0; kb < 2; ++kb)
#pragma unroll
      for (int dt = 0; dt < 8; ++dt) {
        const char* vp = Vc + (32 * kb) * 256 + ((dt ^ vsw) << 5);
        const v4i16_t v0 = __builtin_amdgcn_ds_read_tr16_b64_v4i16((__attribute__((address_space(3))) v4i16_t*)vp);
        const v4i16_t v1 = __builtin_amdgcn_ds_read_tr16_b64_v4i16((__attribute__((address_space(3))) v4i16_t*)(vp + 16 * 256));
        bf16x8 vf; vf[0] = v0[0]; vf[1] = v0[1]; vf[2] = v0[2]; vf[3] = v0[3]; vf[4] = v1[0]; vf[5] = v1[1]; vf[6] = v1[2]; vf[7] = v1[3];
        o[0][dt] = mfma16(vf, pf[0][kb], o[0][dt]);
        o[1][dt] = mfma16(vf, pf[1][kb], o[1][dt]);
      }
    ATTN_WAIT_BARRIER(0);
  }
#pragma unroll
  for (int mp = 0; mp < 2; ++mp) { float lsum = l_run[mp]; lsum += __shfl_xor(lsum, 16); lsum += __shfl_xor(lsum, 32); l_run[mp] = lsum; }
  const float* sg = p.in[19] + (size_t)l * 128;
  {
    const float i1 = rcp_f(l_run[0]), i2 = lam * rcp_f(l_run[1]);
    float ss = 0.f;
#pragma unroll
    for (int dt = 0; dt < 8; ++dt) {
      o[0][dt] = o[0][dt] * i1 - o[1][dt] * i2;
#pragma unroll
      for (int r = 0; r < 4; ++r) ss += o[0][dt][r] * o[0][dt][r];
    }
    ss += __shfl_xor(ss, 16); ss += __shfl_xor(ss, 32);
    const float rs = rsqrtf(ss * (1.f / 128.f) + 1e-5f) * (1.f - lam_init);
    bf16_t* rowp = P + (size_t)(b * S + qrow) * PC + D_G + 128 * h + 4 * g;
#pragma unroll
    for (int dt = 0; dt < 8; ++dt) {
      const u32x2 gt = *(const u32x2*)(rowp + 16 * dt);
      const f32x4 sgv = *(const f32x4*)(sg + 16 * dt + 4 * g);
      u32x2 w;
      w.x = pk2(o[0][dt][0] * rs * sgv[0] * silu_f(bflo(gt.x)), o[0][dt][1] * rs * sgv[1] * silu_f(bfhi(gt.x)));
      w.y = pk2(o[0][dt][2] * rs * sgv[2] * silu_f(bflo(gt.y)), o[0][dt][3] * rs * sgv[3] * silu_f(bfhi(gt.y)));
      if (!dry) *(u32x2*)(rowp + 16 * dt) = w;
    }
  }
}

DEVI void attn_tile_A(const Params& p, int l, int c, int tile, char* lds) {
  unsigned char* ws = p.ws;
  LAUNDER_GP(ws);
  bf16_t* P = (bf16_t*)(ws + WS_P);
  const float* tabg = (const float*)(ws + WS_TAB);
  int tid = threadIdx.x; asm volatile("" : "+v"(tid));
  const int lane = tid & 63, wave = tid >> 6, q = lane & 15, g = lane >> 4;
  const int gi = tile >> 9, idx = tile & 511, b = idx >> 7, h = (idx >> 4) & 7, rn = idx & 15;
  const int dsh = 2 * gi, dil = 1 << dsh, nb2 = 16 >> dsh;
  const int r = rn / nb2, n2 = rn - r * nb2;
  float* tl = (float*)(lds + 49152);
  for (int i = tid; i < 384; i += 256) tl[i] = tabg[TB_BA2 + (gi * 8 + h) * 384 + i];
  __syncthreads();
  const bf16_t* base = P + (size_t)(b * S + r) * PC;
  const size_t st = (size_t)dil * PC;
  f32x4 o[4][2]; float m_run[2], l_run[2];
  const int kt_lo = (n2 == 0) ? 1 : 0, kt_hi = (n2 == nb2 - 1) ? 3 : 4;
  attn_pass<4, 2, true, 3>(base + (size_t)(128 * n2) * st + A_Q + 64 * h, st, base + A_K + 64 * h, st, base + A_V + 64 * h, st,
                           kt_lo, kt_hi, 128 * n2 - 64, 128 * n2, tl, 192, lds, o, m_run, l_run);
  bf16_t* AT = (bf16_t*)(ws + WS_AT) + (size_t)gi * TC * 512;
  float* LSE = (float*)(ws + WS_LSE) + (size_t)gi * TC * 8;
#pragma unroll
  for (int qs = 0; qs < 2; ++qs) {
    const int ell = 128 * n2 + wave * 32 + 16 * qs + q;
    const size_t tok = (size_t)(b * S) + (size_t)ell * dil + r;
    const float inv = rcp_f(l_run[qs]);
#pragma unroll
    for (int dt = 0; dt < 4; ++dt) {
      u32x2 w; w.x = pk2(o[dt][qs][0] * inv, o[dt][qs][1] * inv); w.y = pk2(o[dt][qs][2] * inv, o[dt][qs][3] * inv);
      *(u32x2*)(AT + tok * 512 + 64 * h + 16 * dt + 4 * g) = w;
    }
    if (g == 0) LSE[tok * 8 + h] = m_run[qs] + log2f(l_run[qs]);
  }
}

DEVI bf16x8 frag_lo(const f32x4 v) { u32x4 w; w.x = pk2(v[0], v[1]); w.y = pk2(v[2], v[3]); w.z = 0u; w.w = 0u; return __builtin_bit_cast(bf16x8, w); }
DEVI void scan_item(const Params& p, int l, int c, int item, char* lds) {
  unsigned char* ws = p.ws;
  LAUNDER_GP(ws);
  const bf16_t* P = (const bf16_t*)(ws + WS_P);
  int tid = threadIdx.x; asm volatile("" : "+v"(tid));
  const int lane = tid & 63, wave = tid >> 6, q = lane & 15, g = lane >> 4;
  const int e = item & 1, h = (item >> 1) & 7, b = item >> 4;
  const int ul = tid >> 4, cg = tid & 15;
  constexpr int STGB = 10240, IMGB = 17664;
  char* IMG0 = lds + 2 * STGB;
  float* MU = (float*)(lds + 2 * STGB + 2 * IMGB);
  for (int i = tid; i < 512; i += 256) { char* ib = IMG0 + (i >> 8) * IMGB; ((unsigned*)(ib + 12288))[i & 255] = 0u; ((unsigned*)(ib + 14336))[i & 255] = 0u; }
  const f32x4 k_k = *(const f32x4*)(p.in[11] + (size_t)l * 512 + 64 * h + 4 * cg);
  const int cl = 16 * wave + q;
  const float w0c = p.in[7][(size_t)l * 1024 + e * 512 + 64 * h + cl];
  const float a0c = p.in[9][(size_t)l * 1024 + e * 512 + 64 * h + cl];
  const float k_ac = p.in[12][(size_t)l * 512 + 64 * h + cl];
  const float r_kc = p.in[13][(size_t)l * 512 + 64 * h + cl];
  bf16x8 wuf[2], auf[2];
  {
    const float* wup = p.in[8] + (size_t)l * 2 * 64 * 512 + (size_t)e * 64 * 512 + 64 * h + 16 * wave + q;
    const float* aup = p.in[10] + (size_t)l * 2 * 64 * 512 + (size_t)e * 64 * 512 + 64 * h + 16 * wave + q;
#pragma unroll
    for (int ks = 0; ks < 2; ++ks) {
      u32x4 w, a;
#pragma unroll
      for (int jj = 0; jj < 4; ++jj) {
        const int rho = 32 * ks + 8 * g + 2 * jj;
        w[jj] = pk2(wup[(size_t)rho * 512], wup[(size_t)(rho + 1) * 512]);
        a[jj] = pk2(aup[(size_t)rho * 512], aup[(size_t)(rho + 1) * 512]);
      }
      wuf[ks] = __builtin_bit_cast(bf16x8, w); auf[ks] = __builtin_bit_cast(bf16x8, a);
    }
  }
  const bf16_t* Pb = P + (size_t)(b * S) * PC;
  bf16_t* YS = (bf16_t*)(ws + WS_YS) + (size_t)e * TC * 512 + (size_t)(b * S) * 512 + 64 * h + 16 * wave + q;
  float* BONP = (float*)(ws + WS_BONP) + (size_t)e * TC * 32 + (size_t)(b * S) * 32 + h * 4 + wave;
  f32x4 ST[4];
#pragma unroll
  for (int jt = 0; jt < 4; ++jt) ST[jt] = (f32x4){0.f, 0.f, 0.f, 0.f};
  {
    const float* mu = p.in[6] + (size_t)l * 2 * 1792;
    for (int i = tid; i < 640; i += 256) {
      const int s2 = i / 320, j = i - s2 * 320, seg = j >> 6, ch = j & 63;
      const int col = (seg == 0 ? 0 : seg == 1 ? 512 : seg == 2 ? 1024 : seg == 3 ? 1536 : 1664) + (seg < 3 ? 64 * h : 64 * e) + ch;
      MU[i] = mu[s2 * 1792 + col];
    }
  }
  __syncthreads();
  const int tl_ = (e == 0) ? ul : (15 - ul);
  const int pB = 32 * (cl >> 5) + 8 * ((cl >> 2) & 3) + 4 * ((cl >> 4) & 1) + (cl & 3);
  u32x2 pre[2][15];
  auto issue_loads = [&](int chunk, int sl) {
    const int t = ((e == 0) ? 16 * chunk : (S - 16 - 16 * chunk)) + tl_;
    const int tm = t > 0 ? t - 1 : 0, tp = t < S - 1 ? t + 1 : S - 1;
#pragma unroll
    for (int seg = 0; seg < 5; ++seg) {
      const int col = (seg == 0 ? B_R : seg == 1 ? B_K : seg == 2 ? B_V : seg == 3 ? B_WD : B_AD) + (seg < 3 ? 64 * h : 64 * e) + 4 * cg;
      pre[sl][3 * seg + 1] = *(const u32x2*)(Pb + (size_t)t * PC + col);
      pre[sl][3 * seg + 0] = *(const u32x2*)(Pb + (size_t)tm * PC + col);
      pre[sl][3 * seg + 2] = *(const u32x2*)(Pb + (size_t)tp * PC + col);
    }
  };
  float xv[2][4];
  auto stage1 = [&](int ch, int sl) {
    char* sb = lds + sl * STGB;
    const int t = ((e == 0) ? 16 * ch : (S - 16 - 16 * ch)) + tl_;
    const float zm = (t > 0) ? 1.f : 0.f, zp = (t < S - 1) ? 1.f : 0.f;
    float xs[5][4];
#pragma unroll
    for (int seg = 0; seg < 5; ++seg) {
      const u32x2 cm = pre[sl][3 * seg], c0 = pre[sl][3 * seg + 1], cp = pre[sl][3 * seg + 2];
      const float x0[4] = {bflo(c0.x), bfhi(c0.x), bflo(c0.y), bfhi(c0.y)};
      const float xm[4] = {bflo(cm.x) * zm, bfhi(cm.x) * zm, bflo(cm.y) * zm, bfhi(cm.y) * zm};
      const float xp[4] = {bflo(cp.x) * zp, bfhi(cp.x) * zp, bflo(cp.y) * zp, bfhi(cp.y) * zp};
      const f32x4 m0 = *(const f32x4*)(MU + 64 * seg + 4 * cg), m1 = *(const f32x4*)(MU + 320 + 64 * seg + 4 * cg);
#pragma unroll
      for (int j = 0; j < 4; ++j) xs[seg][j] = x0[j] + m0[j] * (xm[j] - x0[j]) + m1[j] * (xp[j] - x0[j]);
    }
    float th[4];
#pragma unroll
    for (int j = 0; j < 4; ++j) th[j] = 1.f - 2.f * rcp_f(1.f + __expf(2.f * xs[3][j]));
    u32x2 w; w.x = pk2(th[0], th[1]); w.y = pk2(th[2], th[3]);
    *(u32x2*)(sb + (ul * 64 + 4 * cg) * 2) = w;
    u32x2 a; a.x = pk2(xs[4][0], xs[4][1]); a.y = pk2(xs[4][2], xs[4][3]);
    *(u32x2*)(sb + 2048 + (ul * 64 + 4 * cg) * 2) = a;
    f32x4 kk; float ss = 0.f;
#pragma unroll
    for (int j = 0; j < 4; ++j) { kk[j] = xs[1][j] * k_k[j]; ss += kk[j] * kk[j]; xv[sl][j] = xs[2][j]; }
    ss = row16_sum(ss);
    kk = kk * rcp_f(fmaxf(sqrtf(ss), 1e-12f));
    u32x2 wr; wr.x = pk2(xs[0][0], xs[0][1]); wr.y = pk2(xs[0][2], xs[0][3]);
    u32x2 wk; wk.x = pk2(xs[1][0], xs[1][1]); wk.y = pk2(xs[1][2], xs[1][3]);
    u32x2 wkk; wkk.x = pk2(kk[0], kk[1]); wkk.y = pk2(kk[2], kk[3]);
    *(u32x2*)(sb + 4096 + (ul * 64 + 4 * cg) * 2) = wr;
    *(u32x2*)(sb + 6144 + (ul * 64 + 4 * cg) * 2) = wk;
    *(u32x2*)(sb + 8192 + (ul * 64 + 4 * cg) * 2) = wkk;
  };
  auto stage2 = [&](int ch, int sl) {
    const char* sb = lds + sl * STGB; char* ib = IMG0 + sl * IMGB;
    const bf16_t* LAw = (const bf16_t*)sb; const bf16_t* LAa = (const bf16_t*)(sb + 2048);
    const bf16_t* XR = (const bf16_t*)(sb + 4096); const bf16_t* XK = (const bf16_t*)(sb + 6144); const bf16_t* XKK = (const bf16_t*)(sb + 8192);
    const int tlo = (e == 0) ? 16 * ch : (S - 16 - 16 * ch);
    char* AT = ib; char* RT = ib + 2048; char* BT = ib + 4096; char* KT = ib + 6144; char* BK = ib + 8192; char* VI = ib + 15360; float* GC = (float*)(ib + 17408);
#pragma unroll
    for (int j = 0; j < 4; ++j) *(bf16_t*)(VI + (4 * cg + j) * 32 + ul * 2) = (bf16_t)(pk2(xv[sl][j], 0.f) & 0xffffu);
    f32x4 aw = (f32x4){0.f, 0.f, 0.f, 0.f}, aa = aw;
#pragma unroll
    for (int ks = 0; ks < 2; ++ks) {
      const bf16x8 fw = *(const bf16x8*)(LAw + q * 64 + 32 * ks + 8 * g);
      const bf16x8 fa = *(const bf16x8*)(LAa + q * 64 + 32 * ks + 8 * g);
      aw = mfma16(fw, wuf[ks], aw); aa = mfma16(fa, auf[ks], aa);
    }
    float lw[4], G[4], av[4], bv[4], kv[4], rv[4], bo[4];
#pragma unroll
    for (int r = 0; r < 4; ++r) {
      const int tau = 4 * g + r;
      const float rr = bf1(XR[tau * 64 + cl]), kx = bf1(XK[tau * 64 + cl]), kkx = bf1(XKK[tau * 64 + cl]);
      const float xw = -(w0c + aw[r]);
      const float sp = fmaxf(xw, 0.f) + __logf(1.f + __expf(-fabsf(xw)));
      lw[r] = -__expf(-sp - 0.5f);
      const float asg = rcp_f(1.f + __expf(-(a0c + aa[r])));
      const float ke = kx * (1.f + (asg - 1.f) * k_ac);
      av[r] = -kkx; bv[r] = kkx * asg; kv[r] = ke; rv[r] = rr;
      bo[r] = rr * ke * r_kc;
    }
    G[0] = lw[0]; G[1] = G[0] + lw[1]; G[2] = G[1] + lw[2]; G[3] = G[2] + lw[3];
    float t2 = G[3];
    { float x = __shfl_up(t2, 16); if (lane >= 16) t2 += x; x = __shfl_up(t2, 32); if (lane >= 32) t2 += x; }
    const float offs = t2 - G[3];
    const float Ga = __shfl(t2, q + 48);
    const float gC = __expf(Ga);
    float bh[4], kh[4];
#pragma unroll
    for (int r = 0; r < 4; ++r) {
      const int tau = 4 * g + r;
      const float Gr = G[r] + offs;
      const float eG = __expf(Gr), eGm1 = __expf(Gr - lw[r]), enG = __expf(-Gr), eGC = gC * enG;
      *(bf16_t*)(AT + tau * 128 + pB * 2) = (bf16_t)(pk2(av[r] * eGm1, 0.f) & 0xffffu);
      *(bf16_t*)(RT + tau * 128 + pB * 2) = (bf16_t)(pk2(rv[r] * eG, 0.f) & 0xffffu);
      *(bf16_t*)(BT + tau * 128 + pB * 2) = (bf16_t)(pk2(bv[r] * enG, 0.f) & 0xffffu);
      *(bf16_t*)(KT + tau * 128 + pB * 2) = (bf16_t)(pk2(kv[r] * enG, 0.f) & 0xffffu);
      bh[r] = bv[r] * eGC; kh[r] = kv[r] * eGC;
      const float bs = row16_sum(bo[r]);
      if (q == 0) BONP[(size_t)(tlo + ((e == 0) ? tau : (15 - tau))) * 32] = bs;
    }
    { u32x4 w; w.x = pk2(bh[0], bh[1]); w.y = pk2(bh[2], bh[3]); w.z = pk2(kh[0], kh[1]); w.w = pk2(kh[2], kh[3]); *(u32x4*)(BK + cl * 64 + g * 16) = w; }
    if (g == 0) GC[cl] = gC;
  };
  auto stage5 = [&](char* ib, int rot) {
    const int wv = wave ^ rot;
    const char* AT = ib; const char* RT = ib + 2048; const char* BT = ib + 4096; const char* KT = ib + 6144; char* MKA = ib + 12288; char* MBK = ib + 13312; char* TTI = ib + 14336;
    const char* Aimg = (wv < 2) ? AT : RT;
    const char* Bimg = (wv & 1) ? KT : BT;
    f32x4 m = (f32x4){0.f, 0.f, 0.f, 0.f};
#pragma unroll
    for (int kb = 0; kb < 2; ++kb) m = mfma16(*(const bf16x8*)(Aimg + q * 128 + kb * 64 + g * 16), *(const bf16x8*)(Bimg + q * 128 + kb * 64 + g * 16), m);
#pragma unroll
    for (int r = 0; r < 4; ++r) { const int tau = 4 * g + r; const bool keep = (wv < 2) ? (q < tau) : (q <= tau); m[r] = keep ? m[r] : 0.f; }
    if (wv == 0) {
      f32x4 L = m, LT = (f32x4){0.f, 0.f, 0.f, 0.f};
#pragma unroll
      for (int kb = 0; kb < 2; ++kb) LT = mfma16(*(const bf16x8*)(BT + q * 128 + kb * 64 + g * 16), *(const bf16x8*)(AT + q * 128 + kb * 64 + g * 16), LT);
      f32x4 Pm, PT;
#pragma unroll
      for (int r = 0; r < 4; ++r) { const int sg = 4 * g + r; LT[r] = (sg < q) ? LT[r] : 0.f; const float id = (sg == q) ? 1.f : 0.f; Pm[r] = L[r] + id; PT[r] = LT[r] + id; }
      const f32x4 z4 = (f32x4){0.f, 0.f, 0.f, 0.f};
      const f32x4 L2 = mfma16(frag_lo(LT), frag_lo(L), z4), L2T = mfma16(frag_lo(L), frag_lo(LT), z4);
      const f32x4 P1 = mfma16(frag_lo(PT), frag_lo(L2), Pm), P1T = mfma16(frag_lo(L2), frag_lo(PT), PT);
      const f32x4 L4 = mfma16(frag_lo(L2T), frag_lo(L2), z4), L4T = mfma16(frag_lo(L2), frag_lo(L2T), z4);
      const f32x4 P2 = mfma16(frag_lo(P1T), frag_lo(L4), P1), P2T = mfma16(frag_lo(L4), frag_lo(P1T), P1T);
      const f32x4 L8 = mfma16(frag_lo(L4T), frag_lo(L4), z4);
      const f32x4 P3 = mfma16(frag_lo(P2T), frag_lo(L8), P2);
#pragma unroll
      for (int r = 0; r < 4; ++r) *(bf16_t*)(TTI + (4 * g + r) * 64 + (q >> 2) * 16 + (q & 3) * 2) = (bf16_t)(pk2(P3[r], 0.f) & 0xffffu);
    } else {
      char* img = (wv == 1) ? MKA : MBK;
      const int off = (wv == 2) ? 0 : 8;
#pragma unroll
      for (int r = 0; r < 4; ++r) *(bf16_t*)(img + (4 * g + r) * 64 + (q >> 2) * 16 + off + (q & 3) * 2) = (bf16_t)(pk2(m[r], 0.f) & 0xffffu);
    }
  };
  auto stage6 = [&](int ch, const char* ib) {
    const int tlo = (e == 0) ? 16 * ch : (S - 16 - 16 * ch);
    const char* AT = ib; const char* RT = ib + 2048; const char* BK = ib + 8192; const char* MKA = ib + 12288; const char* MBK = ib + 13312; const char* TTI = ib + 14336;
    const char* VI = ib + 15360; const float* GC = (const float*)(ib + 17408);
    const u32x2 vv = *(const u32x2*)(VI + (16 * wave + q) * 32 + g * 8);
    bf16x8 sf[2];
#pragma unroll
    for (int kb = 0; kb < 2; ++kb) {
      u32x4 w; w.x = pk2(ST[2 * kb][0], ST[2 * kb][1]); w.y = pk2(ST[2 * kb][2], ST[2 * kb][3]);
      w.z = pk2(ST[2 * kb + 1][0], ST[2 * kb + 1][1]); w.w = pk2(ST[2 * kb + 1][2], ST[2 * kb + 1][3]);
      sf[kb] = __builtin_bit_cast(bf16x8, w);
    }
    f32x4 ax = (f32x4){0.f, 0.f, 0.f, 0.f}, ay = ax;
#pragma unroll
    for (int kb = 0; kb < 2; ++kb) {
      ax = mfma16(*(const bf16x8*)(AT + q * 128 + kb * 64 + g * 16), sf[kb], ax);
      ay = mfma16(*(const bf16x8*)(RT + q * 128 + kb * 64 + g * 16), sf[kb], ay);
    }
    { u32x4 w; w.x = 0u; w.y = 0u; w.z = vv.x; w.w = vv.y; ax = mfma16(*(const bf16x8*)(MKA + q * 64 + g * 16), __builtin_bit_cast(bf16x8, w), ax); }
    const f32x4 au = mfma16(*(const bf16x8*)(TTI + q * 64 + g * 16), frag_lo(ax), (f32x4){0.f, 0.f, 0.f, 0.f});
    u32x4 uvw; uvw.x = pk2(au[0], au[1]); uvw.y = pk2(au[2], au[3]); uvw.z = vv.x; uvw.w = vv.y;
    const bf16x8 uvf = __builtin_bit_cast(bf16x8, uvw);
    ay = mfma16(*(const bf16x8*)(MBK + q * 64 + g * 16), uvf, ay);
#pragma unroll
    for (int jt = 0; jt < 4; ++jt) {
      const f32x4 gc4 = *(const f32x4*)(GC + 16 * jt + 4 * g);
      ST[jt] = mfma16(*(const bf16x8*)(BK + (16 * jt + q) * 64 + g * 16), uvf, ST[jt] * gc4);
    }
#pragma unroll
    for (int r = 0; r < 4; ++r) {
      const int tau = 4 * g + r, tok = tlo + ((e == 0) ? tau : (15 - tau));
      YS[(size_t)tok * 512] = (bf16_t)(pk2(ay[r], 0.f) & 0xffffu);
    }
  };
  issue_loads(0, 0); issue_loads(1, 1);
#pragma unroll 1
  for (int cp = 0; cp < S / 32; ++cp) {
    const int c0 = 2 * cp, c1 = 2 * cp + 1;
    stage1(c0, 0); stage1(c1, 1);
    __syncthreads();
    stage2(c0, 0); stage2(c1, 1);
    __syncthreads();
    if (c0 + 2 < S / 16) { issue_loads(c0 + 2, 0); issue_loads(c1 + 2, 1); }
    stage5(IMG0, 0); stage5(IMG0 + IMGB, 1);
    __syncthreads();
    stage6(c0, IMG0); stage6(c1, IMG0 + IMGB);
  }
  __syncthreads();
}

DEVI void ln_apply_rows_q(const Params& p, int l, int c, unsigned* qctr, char* lds) {
  int* s_itemp = (int*)(lds + LDS_CTRL + 16);
  for (;;) {
    __syncthreads();
    if (threadIdx.x == 0) *s_itemp = (int)__hip_atomic_fetch_add(qctr, 16u, __ATOMIC_RELAXED, __HIP_MEMORY_SCOPE_AGENT);
    __syncthreads();
    const int it0 = *s_itemp;
    if (it0 >= TC / 4) break;
    ln_apply_rows(p, l, c, it0, 1 << 30, it0 + 16);
  }
}

DEVI void signal_done(unsigned* c0, unsigned* c1, unsigned n) {
  asm volatile("s_waitcnt vmcnt(0)" ::: "memory");
  __syncthreads();
  if (threadIdx.x == 0 && n) {
    __builtin_amdgcn_fence(__ATOMIC_RELEASE, "agent");
    asm volatile("s_waitcnt vmcnt(0)" ::: "memory");
    __hip_atomic_fetch_add(c0, n, __ATOMIC_RELAXED, __HIP_MEMORY_SCOPE_AGENT);
    if (c1) __hip_atomic_fetch_add(c1, n, __ATOMIC_RELAXED, __HIP_MEMORY_SCOPE_AGENT);
  }
}
DEVI void wait_count(unsigned* ctr, unsigned target) {
  if (threadIdx.x == 0) {
    unsigned sp = 0;
    while (__hip_atomic_load(ctr, __ATOMIC_RELAXED, __HIP_MEMORY_SCOPE_AGENT) < target) { __builtin_amdgcn_s_sleep(2); if (++sp > (1u << 24)) break; }
    __builtin_amdgcn_fence(__ATOMIC_ACQUIRE, "agent");
    asm volatile("s_waitcnt vmcnt(0)" ::: "memory");
  }
  __syncthreads();
}
DEVI void b_panels(const Params& p, int l, int c, char* lds, bool fence) {
  LAUNDER_S(l); LAUNDER_S(c);
  unsigned* W = (unsigned*)(p.ws + WS_CTL) + 64 * (24 + 4 * (l * NCHUNK + c));
  unsigned nb = 0;
  for (int jb = blockIdx.x; jb < 14 * 64; jb += gridDim.x) { p_tile(p, l, c, jb & 63, 16 + (jb >> 6), lds); __syncthreads(); ++nb; }
  if (fence) { signal_done(W + 16, W + 32, nb); return; }
  if (threadIdx.x == 0 && nb) {
    __hip_atomic_fetch_add(W + 16, nb, __ATOMIC_RELAXED, __HIP_MEMORY_SCOPE_AGENT);
    __hip_atomic_fetch_add(W + 32, nb, __ATOMIC_RELAXED, __HIP_MEMORY_SCOPE_AGENT);
  }
}
DEVI void phase_pm(const Params& p, int l, int c, char* lds, bool pre_b = false) {
  LAUNDER_S(l); LAUNDER_S(c);
  unsigned* W = (unsigned*)(p.ws + WS_CTL) + 64 * (24 + 4 * (l * NCHUNK + c));
  unsigned* ctr = (unsigned*)(p.ws + WS_CTL) + 64 * (1 + l * NCHUNK + c);
  int* s_itemp = (int*)(lds + LDS_CTRL + 16);
  const int role = *(const int*)(lds + LDS_CTRL + 20);
  const int nextra = (l == 0 && c == 0) ? 128 : 0;
  constexpr int NB_T = 14 * 64, NN_T = 50 * 64;
  __syncthreads();
  if (threadIdx.x == 0) *s_itemp = (role == 0) ? (int)__hip_atomic_fetch_add(W + 48, 1u, __ATOMIC_RELAXED, __HIP_MEMORY_SCOPE_AGENT) : 64;
  __syncthreads();
  const int my_scan = *s_itemp;
  if (!pre_b) b_panels(p, l, c, lds, true);
  const bool has_ln = !(l == 0 && c == 0);
  const int pl = (c == 0) ? l - 1 : l, pc = (c == 0) ? NCHUNK - 1 : c - 1;
  unsigned* cu_busy = (unsigned*)(p.ws + WS_CTL) + 16384 + *(const int*)(lds + LDS_CTRL + 24);
  if (my_scan < 64) {
    wait_count(W + 16, NB_T);
    if (threadIdx.x == 0) __hip_atomic_store(cu_busy, 1u, __ATOMIC_RELAXED, __HIP_MEMORY_SCOPE_AGENT);
    __builtin_amdgcn_s_setprio(1);
    scan_item(p, l, c, my_scan, lds);
    __builtin_amdgcn_s_setprio(0);
    if (threadIdx.x == 0) __hip_atomic_store(cu_busy, 0u, __ATOMIC_RELAXED, __HIP_MEMORY_SCOPE_AGENT);
  }
  unsigned nd = 0;
  auto yield_to_scan = [&]() {
    __syncthreads();
    if (threadIdx.x == 0) *s_itemp = (int)__hip_atomic_load(cu_busy, __ATOMIC_RELAXED, __HIP_MEMORY_SCOPE_AGENT);
    __syncthreads();
    if (*s_itemp) {
      signal_done(W + 32, nullptr, nd); nd = 0;
      if (has_ln) ln_apply_rows_q(p, pl, pc, W + 8, lds);
      if (threadIdx.x == 0) { unsigned sp = 0; while (__hip_atomic_load(cu_busy, __ATOMIC_RELAXED, __HIP_MEMORY_SCOPE_AGENT) != 0u) { __builtin_amdgcn_s_sleep(16); if (++sp > (1u << 20)) break; } }
      __syncthreads();
    }
  };
  {
    unsigned* Q = (unsigned*)(p.ws + WS_CTL) + 12288 + 64 * 8 * (l * NCHUNK + c);
    const unsigned myx = ((unsigned)__builtin_amdgcn_s_getreg((3 << 11) | 20) & 0xFu) & 7u;
    const int per_q = 50 * 8;
    for (int k = 0; k < 8; ++k) {
      const unsigned x = (myx + (unsigned)k) & 7u;
      const int lim = per_q + ((x == 0u) ? nextra : 0);
      for (;;) {
        yield_to_scan();
        __syncthreads();
        if (threadIdx.x == 0) *s_itemp = (int)__hip_atomic_fetch_add(Q + 64 * x, 1u, __ATOMIC_RELAXED, __HIP_MEMORY_SCOPE_AGENT);
        __syncthreads();
        const int jn = *s_itemp;
        if (jn >= lim) break;
        if (jn < per_q) { const int npp = jn >> 3; p_tile(p, l, c, 8 * (jn & 7) + (int)x, npp < 16 ? npp : npp + 14, lds); }
        else memkv_tile(p, jn - per_q, lds);
        ++nd;
      }
    }
  }
  signal_done(W + 32, nullptr, nd);
  wait_count(W + 32, (unsigned)(NB_T + NN_T + nextra));
  constexpr int N_D = 512, N_C = 512, N_A = 1536, N_M = 256, N_ALL = N_D + N_C + N_A + N_M;
  for (;;) {
    __syncthreads();
    if (threadIdx.x == 0) *s_itemp = (int)atomicAdd(ctr, 1u);
    __syncthreads();
    int it = *s_itemp;
    if (it >= N_ALL) break;
    if (it < N_D) { attn_tile_D(p, l, c, it, lds, 0); continue; } it -= N_D;
    if (it < N_C) { attn_tile_CM(p, l, c, it, false, lds, 0); continue; } it -= N_C;
    if (it < N_A) { attn_tile_A(p, l, c, it, lds); continue; } it -= N_A;
    attn_tile_CM(p, l, c, it, true, lds, 0);
  }
  if (has_ln) ln_apply_rows_q(p, pl, pc, W + 8, lds);
  for (int i = 0; i < 8; ++i) { const int t = blockIdx.x + 512 * i; p_tile_probe<2>(p, l, c, t & 63, (t >> 6) & 63, lds); __syncthreads(); }
  for (;;) {
    __syncthreads();
    if (threadIdx.x == 0) *s_itemp = (int)__hip_atomic_fetch_add(W + 48, 1u, __ATOMIC_RELAXED, __HIP_MEMORY_SCOPE_AGENT);
    __syncthreads();
    const int t = *s_itemp;
    if (t >= 64) break;
    scan_item(p, l, c, t, lds);
  }
}

DEVI void phase_finalize(const Params& p, int l, int c, char* lds, int dry = 0) {
  unsigned char* ws = p.ws;
  LAUNDER_S(l); LAUNDER_S(c); LAUNDER_GP(ws);
  int tid_ = threadIdx.x; LAUNDER_V(tid_);
  bf16_t* P = (bf16_t*)(ws + WS_P);
  const int gt = blockIdx.x * 256 + tid_, GT = gridDim.x * 256;
  {
    const bf16_t* AT = (const bf16_t*)(ws + WS_AT); const float* LSE = (const float*)(ws + WS_LSE);
    for (int i = gt; i < TC * 64; i += GT) {
      const int tok = i >> 6, ch = i & 63, h = ch >> 3;
      const float l0 = LSE[(size_t)tok * 8 + h], l1 = LSE[(size_t)TC * 8 + (size_t)tok * 8 + h], l2 = LSE[(size_t)2 * TC * 8 + (size_t)tok * 8 + h];
      const float mx = fmaxf(l0, fmaxf(l1, l2));
      float w0 = exp2f(l0 - mx), w1 = exp2f(l1 - mx), w2 = exp2f(l2 - mx);
      const float inv = 1.f / (w0 + w1 + w2); w0 *= inv; w1 *= inv; w2 *= inv;
      const u32x4 o0 = *(const u32x4*)(AT + (size_t)tok * 512 + 8 * ch), o1 = *(const u32x4*)(AT + (size_t)TC * 512 + (size_t)tok * 512 + 8 * ch),
                  o2 = *(const u32x4*)(AT + (size_t)2 * TC * 512 + (size_t)tok * 512 + 8 * ch);
      bf16_t* gp = P + (size_t)tok * PC + A_G + 8 * ch;
      const u32x4 gg = *(const u32x4*)gp;
      u32x4 w;
#pragma unroll
      for (int k = 0; k < 4; ++k) {
        const float lo = (w0 * bflo(o0[k]) + w1 * bflo(o1[k]) + w2 * bflo(o2[k])) * silu_f(bflo(gg[k]));
        const float hi = (w0 * bfhi(o0[k]) + w1 * bfhi(o1[k]) + w2 * bfhi(o2[k])) * silu_f(bfhi(gg[k]));
        w[k] = pk2(lo, hi);
      }
      if (!dry) *(u32x4*)gp = w;
    }
  }
  {
    const bf16_t* YS = (const bf16_t*)(ws + WS_YS); const float* BONP = (const float*)(ws + WS_BONP);
    const float* mu = p.in[6] + (size_t)l * 2 * 1792;
    const float* lng = p.in[14] + (size_t)l * 512; const float* lnb = p.in[15] + (size_t)l * 512;
    for (int i = gt; i < TC * 64; i += GT) {
      const int tok = i >> 6, ch = i & 63, h = ch >> 3, t = tok & (S - 1);
      const u32x4 yf = *(const u32x4*)(YS + (size_t)tok * 512 + 8 * ch), yb = *(const u32x4*)(YS + (size_t)TC * 512 + (size_t)tok * 512 + 8 * ch);
      float y[8]; float s = 0.f;
#pragma unroll
      for (int k = 0; k < 4; ++k) { y[2 * k] = bflo(yf[k]) + bflo(yb[k]); y[2 * k + 1] = bfhi(yf[k]) + bfhi(yb[k]); s += y[2 * k] + y[2 * k + 1]; }
      s += __shfl_xor(s, 1); s += __shfl_xor(s, 2); s += __shfl_xor(s, 4);
      const float mean = s * (1.f / 64.f); float s2 = 0.f;
#pragma unroll
      for (int k = 0; k < 8; ++k) { y[k] -= mean; s2 += y[k] * y[k]; }
      s2 += __shfl_xor(s2, 1); s2 += __shfl_xor(s2, 2); s2 += __shfl_xor(s2, 4);
      const float rstd = rsqrtf(s2 * (1.f / 64.f) + 64e-5f);
      const f32x4 bp0 = *(const f32x4*)(BONP + ((size_t)tok * 8 + h) * 4), bp1 = *(const f32x4*)(BONP + (size_t)TC * 32 + ((size_t)tok * 8 + h) * 4);
      const float bon = ((bp0[0] + bp0[1]) + (bp0[2] + bp0[3])) + ((bp1[0] + bp1[1]) + (bp1[2] + bp1[3]));
      const bf16_t* vp = P + (size_t)tok * PC + B_V + 8 * ch;
      const u32x4 v0 = *(const u32x4*)vp;
      const u32x4 vm = (t > 0) ? *(const u32x4*)(vp - PC) : (u32x4){0u, 0u, 0u, 0u};
      const u32x4 vq = (t < S - 1) ? *(const u32x4*)(vp + PC) : (u32x4){0u, 0u, 0u, 0u};
      bf16_t* gp = P + (size_t)tok * PC + B_G + 8 * ch;
      const u32x4 gg = *(const u32x4*)gp;
      u32x4 w;
#pragma unroll
      for (int k = 0; k < 4; ++k) {
        float res[2];
#pragma unroll
        for (int hh = 0; hh < 2; ++hh) {
          const int col = 8 * ch + 2 * k + hh;
          const float x0 = hh ? bfhi(v0[k]) : bflo(v0[k]), xm = hh ? bfhi(vm[k]) : bflo(vm[k]), xp = hh ? bfhi(vq[k]) : bflo(vq[k]);
          const float vs = x0 + mu[1024 + col] * (xm - x0) + mu[1792 + 1024 + col] * (xp - x0);
          const float gn = y[2 * k + hh] * rstd * lng[col] + lnb[col];
          const float gv = hh ? bfhi(gg[k]) : bflo(gg[k]);
          res[hh] = (gn + bon * vs) * silu_f(gv);
        }
        w[k] = pk2(res[0], res[1]);
      }
      if (!dry) *(u32x4*)gp = w;
    }
  }
}

DEVI void phase_ygemm(const Params& p, int l, int c, char* lds) {
  unsigned char* ws = p.ws;
  LAUNDER_S(l); LAUNDER_S(c); LAUNDER_GP(ws);
  int tid_ = threadIdx.x; LAUNDER_V(tid_);
  const int lane = tid_ & 63, wave = tid_ >> 6, wm = wave >> 1, wn = wave & 1, q = lane & 15, g = lane >> 4;
  const bf16_t* HB = (const bf16_t*)(ws + WS_HB) + (size_t)c * TC * DM;
  const bf16_t* P = (const bf16_t*)(ws + WS_P);
  const bf16_t* WG = (const bf16_t*)(ws + WS_WGATE);
  const bf16_t* WB = (const bf16_t*)(ws + WS_WBR);
  bf16_t* Y = (bf16_t*)(ws + WS_AT);
  const float* bg = p.in[23] + (size_t)l * 5120;
  for (int it = blockIdx.x; it < 512; it += gridDim.x) {
    const int xcd = it & 7, loc = it >> 3;
    const int np = xcd, mp = loc;
    const int m0 = mp * 128, n0 = np * 128;
    f32x4 y[4][4]; zero_acc(y);
#pragma unroll 1
    for (int br = 0; br < 5; ++br) {
      const int gcol = br == 0 ? A_G : br == 1 ? B_G : br == 2 ? C_G : br == 3 ? D_G : M_G;
      const int kw = br == 4 ? 256 : 512;
      f32x4 acc[4][4]; zero_acc(acc);
      gemm_core<true>(P + (size_t)m0 * PC + gcol, PC, WB + (size_t)n0 * 2304 + 512 * br, 2304, kw / 64, acc, lds);
      unsigned pp[4][4][2];
#pragma unroll
      for (int j = 0; j < 4; ++j)
#pragma unroll
        for (int i = 0; i < 4; ++i) { pp[j][i][0] = pk2(acc[j][i][0], acc[j][i][1]); pp[j][i][1] = pk2(acc[j][i][2], acc[j][i][3]); }
      zero_acc(acc);
      gemm_core<true>(HB + (size_t)m0 * DM, DM, WG + (size_t)(br * 1024 + n0) * DM, DM, 16, acc, lds);
#pragma unroll
      for (int j = 0; j < 4; ++j) {
        const f32x4 bv = *(const f32x4*)(bg + br * 1024 + n0 + wn * 64 + 16 * j + 4 * g);
#pragma unroll
        for (int i = 0; i < 4; ++i) {
          y[j][i][0] += sigmoid_f(acc[j][i][0] + bv[0]) * bflo(pp[j][i][0]);
          y[j][i][1] += sigmoid_f(acc[j][i][1] + bv[1]) * bfhi(pp[j][i][0]);
          y[j][i][2] += sigmoid_f(acc[j][i][2] + bv[2]) * bflo(pp[j][i][1]);
          y[j][i][3] += sigmoid_f(acc[j][i][3] + bv[3]) * bfhi(pp[j][i][1]);
        }
      }
    }
#pragma unroll
    for (int i = 0; i < 4; ++i) {
      bf16_t* rowp = Y + (size_t)(m0 + wm * 64 + 16 * i + q) * DM + n0 + wn * 64 + 4 * g;
#pragma unroll
      for (int j = 0; j < 4; ++j) { u32x2 w; w.x = pk2(y[j][i][0], y[j][i][1]); w.y = pk2(y[j][i][2], y[j][i][3]); *(u32x2*)(rowp + 16 * j) = w; }
    }
  }
}

DEVI void phase_outgemm(const Params& p, int l, int c, char* lds) {
  unsigned char* ws = p.ws;
  LAUNDER_S(l); LAUNDER_S(c); LAUNDER_GP(ws);
  int tid = threadIdx.x; LAUNDER_V(tid);
  const int lane = tid & 63, wave = tid >> 6, wm = wave >> 1, wn = wave & 1, q = lane & 15, g = lane >> 4;
  const bf16_t* Y = (const bf16_t*)(ws + WS_AT);
  const bf16_t* WO = (const bf16_t*)(ws + WS_WOUT) + (size_t)l * 1024 * 1024;
  float* H = p.out + (size_t)c * TC * DM;
  f32x2* ST = (f32x2*)(ws + WS_STATS) + (size_t)c * TC * 16;
  const float alpha = 1.41421356237309515f;
  for (int it = blockIdx.x; it < 512; it += gridDim.x) {
    const int np = it & 7, mp = it >> 3;
    const int m0 = mp * 128, n0 = np * 128;
    f32x4 acc[4][4]; zero_acc(acc);
    gemm_core(Y + (size_t)m0 * DM, DM, WO + (size_t)n0 * DM, DM, 16, acc, lds);
#pragma unroll
    for (int i = 0; i < 4; ++i) {
      const int row = m0 + wm * 64 + 16 * i + q;
      float* hp = H + (size_t)row * DM + n0 + wn * 64 + 4 * g;
      float s = 0.f;
#pragma unroll
      for (int j = 0; j < 4; ++j) { const f32x4 hv = *(const f32x4*)(hp + 16 * j); acc[j][i] = acc[j][i] + alpha * hv; s += (acc[j][i][0] + acc[j][i][1]) + (acc[j][i][2] + acc[j][i][3]); }
      s += __shfl_xor(s, 16); s += __shfl_xor(s, 32);
      const float mw = s * (1.f / 64.f);
      float m2 = 0.f;
#pragma unroll
      for (int j = 0; j < 4; ++j) { const f32x4 d = acc[j][i] - mw; m2 += (d[0] * d[0] + d[1] * d[1]) + (d[2] * d[2] + d[3] * d[3]); *(f32x4*)(hp + 16 * j) = acc[j][i]; }
      m2 += __shfl_xor(m2, 16); m2 += __shfl_xor(m2, 32);
      if (g == 0) ST[(size_t)row * 16 + np * 2 + wn] = (f32x2){mw, m2};
    }
  }
}

DEVI void ln_apply_rows(const Params& p, int l, int c, int first, int stride, int last) {
  unsigned char* ws = p.ws;
  l = __builtin_amdgcn_readfirstlane(l); c = __builtin_amdgcn_readfirstlane(c);
  LAUNDER_S(l); LAUNDER_S(c); LAUNDER_GP(ws);
  int tid = threadIdx.x; LAUNDER_V(tid);
  const int lane = tid & 63, wave = tid >> 6;
  float* H = p.out + (size_t)c * TC * DM;
  bf16_t* HB = (bf16_t*)(ws + WS_HB) + (size_t)c * TC * DM;
  const f32x2* ST = (const f32x2*)(ws + WS_STATS) + (size_t)c * TC * 16;
  const float* lg = p.in[25] + (size_t)l * DM; const float* lb = p.in[26] + (size_t)l * DM;
  for (int it = first; it < last && it < TC / 4; it += stride == (1 << 30) ? 1 : stride) {
    const int row = it * 4 + wave;
    const f32x2 st = ST[(size_t)row * 16 + (lane & 15)];
    float ms = st.x;
    ms += __shfl_xor(ms, 1); ms += __shfl_xor(ms, 2); ms += __shfl_xor(ms, 4); ms += __shfl_xor(ms, 8);
    const float mean = ms * (1.f / 16.f);
    const float dm = st.x - mean;
    float m2 = st.y + 64.f * dm * dm;
    m2 += __shfl_xor(m2, 1); m2 += __shfl_xor(m2, 2); m2 += __shfl_xor(m2, 4); m2 += __shfl_xor(m2, 8);
    const float rstd = rsqrtf(m2 * (1.f / DM) + 1e-5f);
    f32x4* hp = (f32x4*)(H + (size_t)row * DM);
    u32x2* hbp = (u32x2*)(HB + (size_t)row * DM);
#pragma unroll
    for (int j = 0; j < 4; ++j) {
      const f32x4 x = hp[lane + 64 * j];
      const f32x4 gv = ((const f32x4*)lg)[lane + 64 * j], bv = ((const f32x4*)lb)[lane + 64 * j];
      const f32x4 o = (x - mean) * rstd * gv + bv;
      hp[lane + 64 * j] = o;
      u32x2 w; w.x = pk2(o[0], o[1]); w.y = pk2(o[2], o[3]);
      hbp[lane + 64 * j] = w;
    }
  }
}

#define XB_TMO      128
#define XB_XCNT(j)  (256  + 64 * (j))
#define XB_XSUB(j)  (1280 + 64 * (j))
#define XB_XGEN(j)  (2304 + 64 * (j))
#define XB_TOP      3328
#define XB_TOPGEN   3392
#define XCD_BAR_WORDS 3456
#define XB_SPIN_CAP (1u << 22)
#define LAS __attribute__((address_space(3)))
DEVI unsigned xb_ld(unsigned* p) { return __hip_atomic_load(p, __ATOMIC_RELAXED, __HIP_MEMORY_SCOPE_AGENT); }
DEVI unsigned xb_add(unsigned* p, unsigned v) { return __hip_atomic_fetch_add(p, v, __ATOMIC_RELAXED, __HIP_MEMORY_SCOPE_AGENT); }
DEVI unsigned xb_xcc_id() { return (unsigned)__builtin_amdgcn_s_getreg((3 << 11) | 20) & 0xFu; }
#define XB_SPIN(cond, bar) do { unsigned _sp = 0; while (cond) { __builtin_amdgcn_s_sleep(1); \
    if ((++_sp & 255u) == 0u) { if (xb_ld(&(bar)[XB_TMO])) break; if (_sp > XB_SPIN_CAP) { atomicAdd(&(bar)[XB_TMO], 1u); break; } } } } while (0)
struct XcdBarrier { unsigned* bar; unsigned x; volatile LAS unsigned* st; };
DEVI XcdBarrier xcd_barrier_post(unsigned* bar, volatile LAS unsigned* st) {
  XcdBarrier b; b.bar = bar; b.x = xb_xcc_id(); b.st = st;
  if (threadIdx.x == 0) (void)xb_add(&bar[XB_XCNT(b.x)], 1u);
  return b;
}
DEVI void xcd_barrier_complete(unsigned* bar, unsigned x, unsigned& nloc, unsigned& nx) {
  const unsigned G = gridDim.x * gridDim.y * gridDim.z;
  unsigned sum, cnt, mine, sp = 0u;
  for (;;) {
    sum = 0u; cnt = 0u; mine = 0u;
#pragma unroll
    for (unsigned j = 0; j < 16; ++j) { const unsigned c = xb_ld(&bar[XB_XCNT(j)]); sum += c; cnt += (c > 0u) ? 1u : 0u; mine = (j == x) ? c : mine; }
    if (sum == G) break;
    __builtin_amdgcn_s_sleep(1);
    if ((++sp & 255u) == 0u) { if (xb_ld(&bar[XB_TMO])) break; if (sp > XB_SPIN_CAP) { atomicAdd(&bar[XB_TMO], 1u); break; } }
  }
  nloc = mine > 0u ? mine : 1u; nx = cnt > 0u ? cnt : 1u;
}
DEVI void xcd_barrier1(const XcdBarrier& b) {
  asm volatile("s_waitcnt vmcnt(0)" ::: "memory");
  __syncthreads();
  if (threadIdx.x == 0) {
    unsigned* bar = b.bar;
    __builtin_amdgcn_s_waitcnt(0);
    unsigned nloc = b.st[0], nx = b.st[1];
    if (nloc == 0u) { xcd_barrier_complete(bar, b.x, nloc, nx); b.st[0] = nloc; b.st[1] = nx; }
    const unsigned old = xb_add(&bar[XB_XSUB(b.x)], 1u);
    const unsigned gen = old / nloc;
    if (old + 1u == (gen + 1u) * nloc) {
      __builtin_amdgcn_fence(__ATOMIC_RELEASE, "agent");
      asm volatile("s_waitcnt vmcnt(0)" ::: "memory");
      const unsigned og = xb_add(&bar[XB_TOP], 1u);
      const unsigned tg = og / nx;
      if (og + 1u == (tg + 1u) * nx) xb_add(&bar[XB_TOPGEN], 1u);
      else XB_SPIN(xb_ld(&bar[XB_TOPGEN]) == tg, bar);
      __builtin_amdgcn_fence(__ATOMIC_ACQUIRE, "agent");
      xb_add(&bar[XB_XGEN(b.x)], 1u);
      asm volatile("s_waitcnt vmcnt(0)" ::: "memory");
    } else {
      XB_SPIN(xb_ld(&bar[XB_XGEN(b.x)]) == gen, bar);
      __builtin_amdgcn_fence(__ATOMIC_ACQUIRE, "agent");
      asm volatile("s_waitcnt vmcnt(0)" ::: "memory");
    }
  }
  __syncthreads();
}

DEVI void xcd_barrier(const XcdBarrier& b) {
  xcd_barrier1(b);
#if DUP_PHASE == 9
  xcd_barrier1(b);
#endif
}

constexpr int LDS_BYTES = LDS_BYTES_C;

#if !MEGA
template <int PH>
__global__ void __launch_bounds__(256, 2) k_phase(Params p, int l, int c) {
  __shared__ __attribute__((aligned(16))) char lds[LDS_BYTES];
  if (PH == 0) phase_setup(p, lds);
  if (PH == 1) phase_pm(p, l, c, lds);
  if (PH == 3) phase_finalize(p, l, c, lds);
  if (PH == 4) phase_ygemm(p, l, c, lds);
  if (PH == 5) phase_outgemm(p, l, c, lds);
  if (PH == 6) convert_layer_weights(p, l, blockIdx.x, gridDim.x, (float*)lds);
}
#endif

__global__ void __launch_bounds__(256, 2) k_mega(Params p) {
  __shared__ __attribute__((aligned(16))) char lds[LDS_BYTES];
  cg::grid_group grid = cg::this_grid();
  volatile LAS unsigned* st = (volatile LAS unsigned*)(lds + LDS_CTRL);
  if (threadIdx.x == 0) { st[0] = 0u; st[1] = 0u; }
  __syncthreads();
  XcdBarrier bar = xcd_barrier_post((unsigned*)(p.ws + WS_CTL) + 4096, st);
  if (threadIdx.x == 0) {
    const unsigned hw = (unsigned)__builtin_amdgcn_s_getreg((31 << 11) | 4);
    const unsigned key = (bar.x << 8) | ((hw >> 8) & 0xffu);
    const unsigned slot = atomicAdd((unsigned*)(p.ws + WS_CTL) + 8192 + key, 1u);
    *(volatile int*)(lds + LDS_CTRL + 20) = (int)(slot & 1u);
    *(volatile int*)(lds + LDS_CTRL + 24) = (int)key;
  }
  __syncthreads();
  phase_setup(p, lds);
#if DUP_PHASE == 10
  xcd_barrier(bar);
  phase_setup(p, lds);
#endif
  xcd_barrier(bar);
  if (p.out == nullptr) grid.sync();
#pragma unroll 1
  for (int l = 0; l < 2; ++l) {
#pragma unroll 1
    for (int c = 0; c < NCHUNK; ++c) {
      phase_pm(p, l, c, lds, !(l == 0 && c == 0));
      xcd_barrier(bar);
#if DUP_PHASE == 3
      { int dry = 1; LAUNDER_S(dry); phase_finalize(p, l, c, lds, dry); xcd_barrier(bar); }
#endif
      phase_finalize(p, l, c, lds);
      xcd_barrier(bar);
      {
        constexpr int NREP4 = (DUP_PHASE == 4) ? 2 : 1;
#pragma unroll 1
        for (int rep = 0; rep < NREP4; ++rep) {
          phase_ygemm(p, l, c, lds);
          if (rep == NREP4 - 1) {
            if (c + 1 < NCHUNK) b_panels(p, l, c + 1, lds, false);
            else if (l == 0) convert_layer_weights(p, 1, blockIdx.x, gridDim.x, (float*)lds, 16 * 128);
          }
          xcd_barrier(bar);
        }
      }
      phase_outgemm(p, l, c, lds);
      if (l == 0 && c == NCHUNK - 1) {
        convert_layer_weights(p, 1, 16 * 128 + (int)blockIdx.x, gridDim.x, (float*)lds);
        b_panels(p, 1, 0, lds, false);
      }
      xcd_barrier(bar);
    }
  }
  ln_apply_rows(p, 1, NCHUNK - 1, (int)blockIdx.x, (int)gridDim.x);
}

extern "C" void kernel_launch(void* const* d_in, const int* in_sizes, int n_in, void* d_out, int out_size, void* d_ws, size_t ws_size, hipStream_t stream) {
  Params p{};
  for (int i = 0; i < 27; ++i) p.in[i] = (const float*)d_in[i];
  p.out = (float*)d_out; p.ws = (unsigned char*)d_ws;
  (void)hipMemsetAsync((char*)d_ws + WS_CTL, 0, 131072, stream);
#if MEGA
  static int grid_blocks = 0;
  if (!grid_blocks) {
    int dev = 0, cus = 0, per_cu = 0;
    (void)hipGetDevice(&dev);
    (void)hipDeviceGetAttribute(&cus, hipDeviceAttributeMultiprocessorCount, dev);
    (void)hipOccupancyMaxActiveBlocksPerMultiprocessor(&per_cu, k_mega, 256, 0);
    if (per_cu > 2) per_cu = 2;
    if (per_cu < 1) per_cu = 1;
    grid_blocks = cus * per_cu;
  }
  void* args[] = {&p};
  hipError_t e = hipLaunchCooperativeKernel((void*)k_mega, dim3(grid_blocks), dim3(256), args, 0, stream);
  if (e != hipSuccess) fprintf(stderr, "cooperative launch failed: %s (grid %d)\n", hipGetErrorString(e), grid_blocks);
#else
  const int G = 512;
  hipLaunchKernelGGL(k_phase<0>, dim3(G), dim3(256), 0, stream, p, 0, 0);
  for (int l = 0; l < 2; ++l) {
    if (l == 1) hipLaunchKernelGGL(k_phase<6>, dim3(G), dim3(256), 0, stream, p, 1, 0);
    for (int c = 0; c < NCHUNK; ++c) {
      hipLaunchKernelGGL(k_phase<1>, dim3(G), dim3(256), 0, stream, p, l, c);
      hipLaunchKernelGGL(k_phase<2>, dim3(G), dim3(256), 0, stream, p, l, c);
      hipLaunchKernelGGL(k_phase<3>, dim3(G), dim3(256), 0, stream, p, l, c);
      hipLaunchKernelGGL(k_phase<4>, dim3(G), dim3(256), 0, stream, p, l, c);
      hipLaunchKernelGGL(k_phase<5>, dim3(G), dim3(256), 0, stream, p, l, c);
    }
  }
#endif
}
```

```cpp
#include <hip/hip_runtime.h>
#include <hip/hip_cooperative_groups.h>
#include <stdint.h>
#include <stdio.h>
namespace cg = cooperative_groups;

#ifndef MEGA
#define MEGA 1
#endif
#ifndef DUP_PHASE
#define DUP_PHASE 0
#endif

#define DEVI __device__ __forceinline__
#define LAS __attribute__((address_space(3)))
typedef unsigned short bf16_t;
typedef short bf16x8 __attribute__((ext_vector_type(8)));
typedef float f32x4 __attribute__((ext_vector_type(4)));
typedef float f32x2 __attribute__((ext_vector_type(2)));
typedef unsigned u32x4 __attribute__((ext_vector_type(4)));
typedef unsigned u32x2 __attribute__((ext_vector_type(2)));
typedef __bf16 bf16x2_t __attribute__((ext_vector_type(2)));

constexpr int S = 2048, DM = 1024, NBATCH = 8, T_ALL = NBATCH * S;
constexpr int NB = 4, TC = NB * S, NCHUNK = NBATCH / NB;
constexpr int PC = 8192;
constexpr int A_Q = 0, A_K = 512, A_V = 1024, A_G = 1536;
constexpr int B_R = 2048, B_K = 2560, B_V = 3072, B_WD = 3584, B_AD = 3712, B_G = 3840;
constexpr int C_Q = 4352, C_K = 4864, C_V = 4992, C_G = 5120;
constexpr int D_Q = 5632, D_K = 6144, D_V = 6656, D_G = 7168;
constexpr int M_Q = 7680, M_G = 7936;
constexpr int NMEM = 256;
constexpr float LOG2E = 1.4426950408889634f;
constexpr float NEGBIG = -1e30f;
constexpr int LDS_CTRL = 73728;
constexpr int LDS_BYTES_C = LDS_CTRL + 64;

constexpr size_t MiB = 1u << 20;
constexpr size_t WS_CTL = 0;
constexpr size_t WS_TAB = 1 * MiB;
constexpr size_t WS_WIN = 2 * MiB;
constexpr size_t WS_WGATE = 18 * MiB;
constexpr size_t WS_WBR = 28 * MiB;
constexpr size_t WS_WOUT = 32 * MiB + 512 * 1024;
constexpr size_t WS_WMEM = 36 * MiB + 512 * 1024;
constexpr size_t WS_MEMB = 38 * MiB + 512 * 1024;
constexpr size_t WS_MEMKV = 42 * MiB + 512 * 1024;
constexpr size_t WS_HB = 46 * MiB + 512 * 1024;
constexpr size_t WS_P = 78 * MiB + 512 * 1024;
constexpr size_t WS_AT = 206 * MiB + 512 * 1024;
constexpr size_t WS_LSE = 230 * MiB + 512 * 1024;
constexpr size_t WS_YS = 231 * MiB + 256 * 1024;
constexpr size_t WS_BON = 247 * MiB + 256 * 1024;
constexpr size_t WS_STATS = 248 * MiB;
constexpr size_t WS_BONP = 250 * MiB;
constexpr size_t WS_END = 252 * MiB;
constexpr int TB_COS = 0, TB_SIN = 1024, TB_BD = 2048  , TB_BA = 2048 + 16384  , TB_LAM = 2048 + 16384 + 6144  , TB_BA2 = 24640  ;

struct Params {
  const float* in[27];
  float* out;
  unsigned char* ws;
};

#define LAUNDER_S(x) asm volatile("" : "+s"(x))
#define GAS __attribute__((address_space(1)))
#define LAUNDER_GP(x) do { size_t o_ = 0; asm volatile("" : "+s"(o_)); x += o_; } while (0)
#define LAUNDER_V(x) asm volatile("" : "+v"(x))
DEVI unsigned pk2(float lo, float hi) { f32x2 v = {lo, hi}; return __builtin_bit_cast(unsigned, __builtin_convertvector(v, bf16x2_t)); }
DEVI float bflo(unsigned u) { return __uint_as_float(u << 16); }
DEVI float bfhi(unsigned u) { return __uint_as_float(u & 0xffff0000u); }
DEVI float bf1(bf16_t b) { return __uint_as_float(((unsigned)b) << 16); }
DEVI float rcp_f(float x) { return __builtin_amdgcn_rcpf(x); }
DEVI float silu_f(float x) { return x * rcp_f(1.f + __expf(-x)); }
DEVI float sigmoid_f(float x) { return rcp_f(1.f + __expf(-x)); }
DEVI float wave_sum(float v) {
#pragma unroll
  for (int o = 1; o < 64; o <<= 1) v += __shfl_xor(v, o);
  return v;
}
DEVI float row16_sum(float v) {
  v += __int_as_float(__builtin_amdgcn_update_dpp(0, __float_as_int(v), 0x128, 0xf, 0xf, false));
  v += __int_as_float(__builtin_amdgcn_update_dpp(0, __float_as_int(v), 0x124, 0xf, 0xf, false));
  v += __int_as_float(__builtin_amdgcn_update_dpp(0, __float_as_int(v), 0x122, 0xf, 0xf, false));
  v += __int_as_float(__builtin_amdgcn_update_dpp(0, __float_as_int(v), 0x121, 0xf, 0xf, false));
  return v;
}
#define ATTN_WAIT_BARRIER(N) do { asm volatile("s_waitcnt vmcnt(" #N ")" ::: "memory"); asm volatile("s_waitcnt lgkmcnt(0)" ::: "memory"); __builtin_amdgcn_s_barrier(); } while (0)
DEVI f32x4 mfma16(bf16x8 a, bf16x8 b, f32x4 c) { return __builtin_amdgcn_mfma_f32_16x16x32_bf16(a, b, c, 0, 0, 0); }

DEVI int rel_bucket(int rel) {
  int n = rel < 0 ? -rel : rel;
  int b;
  if (n < 8) b = n; else if (n < 15) b = 8; else if (n < 27) b = 9; else if (n < 50) b = 10; else if (n < 91) b = 11;
  else if (n < 166) b = 12; else if (n < 305) b = 13; else if (n < 559) b = 14; else b = 15;
  return (rel > 0 ? 16 : 0) + b;
}

DEVI void tconv_tile(const float* __restrict__ src, int K, int N, bf16_t* __restrict__ dst, int ldd, int tile, float* lds) {
  int tid = threadIdx.x; LAUNDER_V(tid);
  const int ntn = N >> 6, tk = tile / ntn, tn = tile - tk * ntn, k0 = tk * 64, n0 = tn * 64;
  {
    const int cx = tid & 63, ry = tid >> 6;
#pragma unroll
    for (int i = 0; i < 16; ++i) { const int k = 4 * i + ry; lds[k * 65 + cx] = src[(size_t)(k0 + k) * N + n0 + cx]; }
  }
  __syncthreads();
  {
    const int kx = tid & 7, ny = tid >> 3;
#pragma unroll
    for (int i = 0; i < 2; ++i) {
      const int n = ny + 32 * i; const float* s = lds + (8 * kx) * 65 + n;
      u32x4 o; o.x = pk2(s[0], s[65]); o.y = pk2(s[130], s[195]); o.z = pk2(s[260], s[325]); o.w = pk2(s[390], s[455]);
      *(u32x4*)(dst + (size_t)(n0 + n) * ldd + k0 + 8 * kx) = o;
    }
  }
  __syncthreads();
}

struct TcDesc { const float* src; bf16_t* dst; int N, ldd, k0, n0; };
DEVI TcDesc tc_desc(const Params& p, int l, int it) {
  constexpr int T_IN = 16 * 128, T_G = 16 * 80, T_B = 36 * 16;
  TcDesc d; int r = it;
  if (r < T_IN) { d.src = p.in[5] + (size_t)l * 1024 * 8192; d.dst = (bf16_t*)(p.ws + WS_WIN); d.N = 8192; d.ldd = 1024; }
  else if ((r -= T_IN) < T_G) { d.src = p.in[22] + (size_t)l * 1024 * 5120; d.dst = (bf16_t*)(p.ws + WS_WGATE); d.N = 5120; d.ldd = 1024; }
  else if ((r -= T_G) < T_B) { d.src = p.in[21] + (size_t)l * 2304 * 1024; d.dst = (bf16_t*)(p.ws + WS_WBR); d.N = 1024; d.ldd = 2304; }
  else { r -= T_B; d.src = p.in[24] + (size_t)l * 1024 * 1024; d.dst = (bf16_t*)(p.ws + WS_WOUT) + (size_t)l * 1024 * 1024; d.N = 1024; d.ldd = 1024; }
  const int ntn = d.N >> 6, tk = r / ntn;
  d.k0 = tk * 64; d.n0 = (r - tk * ntn) * 64;
  return d;
}
DEVI void tc_load(const TcDesc& d, float (&v)[16]) {
  int tid = threadIdx.x; LAUNDER_V(tid);
  const int cx = tid & 63, ry = tid >> 6;
#pragma unroll
  for (int i = 0; i < 16; ++i) v[i] = d.src[(size_t)(d.k0 + 4 * i + ry) * d.N + d.n0 + cx];
}
DEVI void tc_store(const TcDesc& d, const float (&v)[16], float* lds) {
  int tid = threadIdx.x; LAUNDER_V(tid);
  {
    const int cx = tid & 63, ry = tid >> 6;
#pragma unroll
    for (int i = 0; i < 16; ++i) lds[(4 * i + ry) * 65 + cx] = v[i];
  }
  __syncthreads();
  {
    const int kx = tid & 7, ny = tid >> 3;
#pragma unroll
    for (int i = 0; i < 2; ++i) {
      const int n = ny + 32 * i; const float* sp = lds + (8 * kx) * 65 + n;
      u32x4 o; o.x = pk2(sp[0], sp[65]); o.y = pk2(sp[130], sp[195]); o.z = pk2(sp[260], sp[325]); o.w = pk2(sp[390], sp[455]);
      *(u32x4*)(d.dst + (size_t)(d.n0 + n) * d.ldd + d.k0 + 8 * kx) = o;
    }
  }
  __syncthreads();
}
DEVI void convert_layer_weights(const Params& p, int l, int first, int stride, float* lds, int last = 16 * 128 + 16 * 80 + 36 * 16 + 16 * 16) {
  if (first >= last) return;
  TcDesc d = tc_desc(p, l, first);
  float v[16];
  tc_load(d, v);
  for (int it = first; it < last; it += stride) {
    const int nx = it + stride;
    TcDesc dn = d; float vn[16];
    if (nx < last) { dn = tc_desc(p, l, nx); tc_load(dn, vn); }
    tc_store(d, v, lds);
    if (nx < last) {
      d = dn;
#pragma unroll
      for (int i = 0; i < 16; ++i) v[i] = vn[i];
    }
  }
}

DEVI void phase_setup(const Params& p, char* ldsc) {
  float* lds = (float*)ldsc;
  unsigned char* ws = p.ws;
  LAUNDER_GP(ws);
  int tid = threadIdx.x; LAUNDER_V(tid);
  const int lane = tid & 63, wave = tid >> 6, G = gridDim.x, bid = blockIdx.x;
  convert_layer_weights(p, 0, bid, G, lds);
  for (int it = bid; it < 2 * 128; it += G) {
    const int l = it >> 7;
    tconv_tile(p.in[20] + (size_t)l * 1024 * 512, 1024, 512, (bf16_t*)(ws + WS_WMEM) + (size_t)l * 512 * 1024, 1024, it & 127, lds);
  }
  {
    const float* x = p.in[0]; const float* g = p.in[2]; const float* b = p.in[3];
    bf16_t* hb = (bf16_t*)(ws + WS_HB);
    int row = bid * 4 + wave;
    f32x4 v[4];
    if (row < T_ALL) {
      const f32x4* xr = (const f32x4*)(x + (size_t)row * DM) + lane;
#pragma unroll
      for (int j = 0; j < 4; ++j) v[j] = xr[64 * j];
    }
    for (; row < T_ALL; row += G * 4) {
      const int nrow = row + G * 4;
      f32x4 vn[4];
      if (nrow < T_ALL) {
        const f32x4* xr = (const f32x4*)(x + (size_t)nrow * DM) + lane;
#pragma unroll
        for (int j = 0; j < 4; ++j) vn[j] = xr[64 * j];
      }
      float s = 0.f;
#pragma unroll
      for (int j = 0; j < 4; ++j) s += (v[j].x + v[j].y) + (v[j].z + v[j].w);
      const float mean = wave_sum(s) * (1.f / DM); float s2 = 0.f;
#pragma unroll
      for (int j = 0; j < 4; ++j) { v[j] = v[j] - mean; s2 += (v[j].x * v[j].x + v[j].y * v[j].y) + (v[j].z * v[j].z + v[j].w * v[j].w); }
      const float rstd = rsqrtf(wave_sum(s2) * (1.f / DM) + 1e-5f);
#pragma unroll
      for (int j = 0; j < 4; ++j) {
        const f32x4 gg = ((const f32x4*)g)[lane + 64 * j], bb = ((const f32x4*)b)[lane + 64 * j];
        f32x4 o = v[j] * rstd * gg + bb;
        ((f32x4*)(p.out + (size_t)row * DM))[lane + 64 * j] = o;
        u32x2 w; w.x = pk2(o.x, o.y); w.y = pk2(o.z, o.w);
        ((u32x2*)(hb + (size_t)row * DM))[lane + 64 * j] = w;
      }
      if (nrow < T_ALL) {
#pragma unroll
        for (int j = 0; j < 4; ++j) v[j] = vn[j];
      }
    }
  }
  {
    const float* mem = p.in[1]; bf16_t* mb = (bf16_t*)(ws + WS_MEMB);
    for (int i = bid * 256 + tid; i < NBATCH * NMEM * DM / 8; i += G * 256) {
      const f32x4 a = ((const f32x4*)mem)[2 * i], b = ((const f32x4*)mem)[2 * i + 1];
      u32x4 o; o.x = pk2(a.x, a.y); o.y = pk2(a.z, a.w); o.z = pk2(b.x, b.y); o.w = pk2(b.z, b.w);
      ((u32x4*)mb)[i] = o;
    }
  }
  {
    float* tab = (float*)(ws + WS_TAB);
    const float* rel_bias = p.in[4];
    const int gt = bid * 256 + tid, GT = G * 256;
    for (int i = gt; i < 1024; i += GT) {
      const int pos = i >> 4, c = i & 15;
      const float freq = powf(10000.f, -(float)c / 16.f);
      const float ang = (float)pos * freq;
      tab[TB_COS + i] = cosf(ang); tab[TB_SIN + i] = sinf(ang);
    }
    for (int i = gt; i < 4 * 4096; i += GT) {
      const int h = i >> 12, idx = i & 4095, rel = idx - 2047;
      tab[TB_BD + i] = (idx < 4095) ? rel_bias[rel_bucket(rel) * 12 + 8 + h] * LOG2E : 0.f;
    }
    for (int i = gt; i < 3 * 8 * 256; i += GT) {
      const int gi = i >> 11, h = (i >> 8) & 7, idx = i & 255, off = idx - 128;
      const int dil = gi == 0 ? 1 : (gi == 1 ? 4 : 16);
      const bool ok = off >= -64 && off <= 64;
      tab[TB_BA + i] = ok ? rel_bias[rel_bucket(off * dil) * 12 + h] * LOG2E : NEGBIG;
    }
    for (int i = gt; i < 3 * 8 * 384; i += GT) {
      const int gi = i / 3072, rem = i - gi * 3072, h = rem / 384, idx = rem - h * 384, off = idx - 192;
      const int dil = gi == 0 ? 1 : (gi == 1 ? 4 : 16);
      const bool ok = off >= -64 && off <= 64;
      tab[TB_BA2 + i] = ok ? rel_bias[rel_bucket(off * dil) * 12 + h] * LOG2E : 2.f * NEGBIG;
    }
    if (gt < 2) {
      const float* dl = p.in[18] + (size_t)gt * 256;
      float s1 = 0.f, s2 = 0.f;
      for (int j = 0; j < 64; ++j) { s1 += dl[j] * dl[64 + j]; s2 += dl[128 + j] * dl[192 + j]; }
      const float lam_init = 0.8f - 0.6f * expf(-0.3f * (float)gt);
      tab[TB_LAM + gt] = expf(s1) - expf(s2) + lam_init;
    }
  }
}

template <bool LOWREG = false>
DEVI void gemm_core(const bf16_t* __restrict__ Ag, int lda, const bf16_t* __restrict__ Bg, int ldb, int nk, f32x4 (&acc)[4][4], char* lds) {
  int tid = threadIdx.x;
  asm volatile("" : "+v"(tid));
  const int lane = tid & 63, wave = tid >> 6, wm = wave >> 1, wn = wave & 1;
  char* As = lds; char* Bs = lds + 32768;
  const int srow = 8 * wave + (lane >> 3), sch = (lane & 7) ^ (lane >> 3);
  const bf16_t* ap = Ag + (size_t)srow * lda + sch * 8;
  const bf16_t* bp = Bg + (size_t)srow * ldb + sch * 8;
#pragma unroll
  for (int i = 0; i < 4; ++i) {
    __builtin_amdgcn_global_load_lds((const unsigned*)(ap + (size_t)(32 * i) * lda), (unsigned*)(As + (4 * i + wave) * 1024), 16, 0, 0);
    __builtin_amdgcn_global_load_lds((const unsigned*)(bp + (size_t)(32 * i) * ldb), (unsigned*)(Bs + (4 * i + wave) * 1024), 16, 0, 0);
  }
  asm volatile("s_waitcnt vmcnt(0)" ::: "memory");
  __syncthreads();
  const int frow = (lane & 15) * 128, fg = lane >> 4, fx = lane & 7;
  for (int kt = 0; kt < nk; ++kt) {
    const int cur = kt & 1;
    if (kt + 1 < nk) {
      ap += 64; bp += 64;
      char* Aw = As + (cur ^ 1) * 16384; char* Bw = Bs + (cur ^ 1) * 16384;
#pragma unroll
      for (int i = 0; i < 4; ++i) {
        __builtin_amdgcn_global_load_lds((const unsigned*)(ap + (size_t)(32 * i) * lda), (unsigned*)(Aw + (4 * i + wave) * 1024), 16, 0, 0);
        __builtin_amdgcn_global_load_lds((const unsigned*)(bp + (size_t)(32 * i) * ldb), (unsigned*)(Bw + (4 * i + wave) * 1024), 16, 0, 0);
      }
    }
    const char* Ab = As + cur * 16384 + wm * 8192 + frow;
    const char* Bb = Bs + cur * 16384 + wn * 8192 + frow;
#pragma unroll
    for (int ks = 0; ks < 2; ++ks) {
      const int co = ((4 * ks + fg) ^ fx) << 4;
      bf16x8 af[4], bf[4];
#pragma unroll
      for (int i = 0; i < 4; ++i) { af[i] = *(const bf16x8*)(Ab + i * 2048 + co); bf[i] = *(const bf16x8*)(Bb + i * 2048 + co); }
#pragma unroll
      for (int j = 0; j < 4; ++j)
#pragma unroll
        for (int i = 0; i < 4; ++i) acc[j][i] = mfma16(bf[j], af[i], acc[j][i]);
      if (LOWREG) __builtin_amdgcn_sched_barrier(0);
    }
    asm volatile("s_waitcnt vmcnt(0)" ::: "memory");
    __syncthreads();
  }
}

DEVI void zero_acc(f32x4 (&acc)[4][4]) {
#pragma unroll
  for (int j = 0; j < 4; ++j)
#pragma unroll
    for (int i = 0; i < 4; ++i) acc[j][i] = (f32x4){0.f, 0.f, 0.f, 0.f};
}

DEVI void gemm_core_256(const bf16_t* __restrict__ Ag, int lda, const bf16_t* __restrict__ Bg, int ldb, int nk, f32x4 (&acc)[4][8], char* lds) {
  int tid = threadIdx.x;
  asm volatile("" : "+v"(tid));
  const int lane = tid & 63, wave = tid >> 6, wm = wave >> 1, wn = wave & 1;
  char* As = lds; char* Bs = lds + 49152;
  const int srow = lane >> 2, sch = (lane & 3) ^ ((lane >> 3) & 3);
  const bf16_t* ap = Ag + (size_t)(16 * wave + srow) * lda + sch * 8;
  const bf16_t* bp = Bg + (size_t)(16 * wave + srow) * ldb + sch * 8;
#pragma unroll
  for (int st = 0; st < 2; ++st) {
#pragma unroll
    for (int i = 0; i < 4; ++i) __builtin_amdgcn_global_load_lds((const unsigned*)(ap + (size_t)(64 * i) * lda), (unsigned*)(As + st * 16384 + (4 * i + wave) * 1024), 16, 0, 0);
#pragma unroll
    for (int i = 0; i < 2; ++i) __builtin_amdgcn_global_load_lds((const unsigned*)(bp + (size_t)(64 * i) * ldb), (unsigned*)(Bs + st * 8192 + (4 * i + wave) * 1024), 16, 0, 0);
    ap += 32; bp += 32;
  }
  ATTN_WAIT_BARRIER(6);
  const int q = lane & 15, g = lane >> 4;
  const int foff = q * 64 + ((g ^ ((q >> 1) & 3)) << 4);
  int slot = 0;
  for (int kt = 0; kt < nk; ++kt) {
    if (kt + 2 < nk) {
      int ns = slot + 2; if (ns >= 3) ns -= 3;
      char* Aw = As + ns * 16384; char* Bw = Bs + ns * 8192;
#pragma unroll
      for (int i = 0; i < 4; ++i) __builtin_amdgcn_global_load_lds((const unsigned*)(ap + (size_t)(64 * i) * lda), (unsigned*)(Aw + (4 * i + wave) * 1024), 16, 0, 0);
#pragma unroll
      for (int i = 0; i < 2; ++i) __builtin_amdgcn_global_load_lds((const unsigned*)(bp + (size_t)(64 * i) * ldb), (unsigned*)(Bw + (4 * i + wave) * 1024), 16, 0, 0);
      ap += 32; bp += 32;
    }
    const char* Ab = As + slot * 16384 + wm * 8192 + foff;
    const char* Bb = Bs + slot * 8192 + wn * 4096 + foff;
    bf16x8 bf[4];
#pragma unroll
    for (int j = 0; j < 4; ++j) bf[j] = *(const bf16x8*)(Bb + j * 1024);
#pragma unroll
    for (int i = 0; i < 8; ++i) {
      const bf16x8 af = *(const bf16x8*)(Ab + i * 1024);
#pragma unroll
      for (int j = 0; j < 4; ++j) acc[j][i] = mfma16(bf[j], af, acc[j][i]);
    }
    if (kt + 2 < nk) ATTN_WAIT_BARRIER(6); else ATTN_WAIT_BARRIER(0);
    ++slot; if (slot >= 3) slot = 0;
  }
}

DEVI void ln_apply_rows(const struct Params& p, int l, int c, int first, int stride, int last = TC / 4);
DEVI void p_tile(const Params& p, int l, int c, int mp, int np, char* lds) {
  unsigned char* ws = p.ws;
  LAUNDER_GP(ws);
  int t2_ = threadIdx.x; LAUNDER_V(t2_);
  const int lane = t2_ & 63, wave = t2_ >> 6, wm = wave >> 1, wn = wave & 1, q = lane & 15, g = lane >> 4;
  const bf16_t* HB = (const bf16_t*)(ws + WS_HB) + (size_t)c * TC * DM;
  const bf16_t* WIN = (const bf16_t*)(ws + WS_WIN);
  bf16_t* P = (bf16_t*)(ws + WS_P);
  const float* tab = (const float*)(ws + WS_TAB);
  const int m0 = mp * 128, n0 = np * 128;
  f32x4 acc[4][4]; zero_acc(acc);
  gemm_core(HB + (size_t)m0 * DM, DM, WIN + (size_t)n0 * DM, DM, 16, acc, lds);
  const int ncol0 = n0 + wn * 64;
  if (ncol0 >= C_Q && ncol0 < C_V) {
    const float* gain = (ncol0 < C_K ? p.in[16] : p.in[17]) + (size_t)l * 64;
    float gn[4][4];
#pragma unroll
    for (int j = 0; j < 4; ++j)
#pragma unroll
      for (int r = 0; r < 4; ++r) gn[j][r] = gain[16 * j + 4 * g + r];
#pragma unroll
    for (int i = 0; i < 4; ++i) {
      float ss = 0.f;
#pragma unroll
      for (int j = 0; j < 4; ++j)
#pragma unroll
        for (int r = 0; r < 4; ++r) ss += acc[j][i][r] * acc[j][i][r];
      ss += __shfl_xor(ss, 16); ss += __shfl_xor(ss, 32);
      const float rinv = rsqrtf(ss * (1.f / 64.f) + 1e-6f);
      const int t = (m0 + wm * 64 + 16 * i + q) & (S - 1), prow = t >> 6, pcol = t & 63;
      const f32x4 cr = *(const f32x4*)(tab + TB_COS + prow * 16 + 4 * g), sr = *(const f32x4*)(tab + TB_SIN + prow * 16 + 4 * g);
      const f32x4 cc = *(const f32x4*)(tab + TB_COS + pcol * 16 + 4 * g), sc = *(const f32x4*)(tab + TB_SIN + pcol * 16 + 4 * g);
#pragma unroll
      for (int r = 0; r < 4; ++r) {
        const float u1 = acc[0][i][r] * rinv * gn[0][r], u2 = acc[1][i][r] * rinv * gn[1][r];
        const float w1 = acc[2][i][r] * rinv * gn[2][r], w2 = acc[3][i][r] * rinv * gn[3][r];
        acc[0][i][r] = u1 * cr[r] - u2 * sr[r]; acc[1][i][r] = u1 * sr[r] + u2 * cr[r];
        acc[2][i][r] = w1 * cc[r] - w2 * sc[r]; acc[3][i][r] = w1 * sc[r] + w2 * cc[r];
      }
    }
  }
  char* wl = lds + wave * 8704;
#pragma unroll
  for (int i = 0; i < 4; ++i)
#pragma unroll
    for (int j = 0; j < 4; ++j) { u32x2 w; w.x = pk2(acc[j][i][0], acc[j][i][1]); w.y = pk2(acc[j][i][2], acc[j][i][3]); *(u32x2*)(wl + (16 * i + q) * 136 + (16 * j + 4 * g) * 2) = w; }
  bf16_t* ob = P + (size_t)(m0 + wm * 64) * PC + ncol0;
#pragma unroll
  for (int k = 0; k < 8; ++k) {
    const int idx = lane + 64 * k, row = idx >> 3, ch = idx & 7;
    const u32x2 lo = *(const u32x2*)(wl + row * 136 + ch * 16), hi = *(const u32x2*)(wl + row * 136 + ch * 16 + 8);
    *(u32x4*)(ob + (size_t)row * PC + ch * 8) = (u32x4){lo.x, lo.y, hi.x, hi.y};
  }
}
DEVI void memkv_tile(const Params& p, int e, char* lds) {
  unsigned char* ws = p.ws;
  LAUNDER_GP(ws);
  int t2_ = threadIdx.x; LAUNDER_V(t2_);
  const int lane = t2_ & 63, wave = t2_ >> 6, wm = wave >> 1, wn = wave & 1, q = lane & 15, g = lane >> 4;
  const int ll = e >> 6, mp = (e >> 2) & 15, np = e & 3;
  const int m0 = mp * 128, n0 = np * 128;
  f32x4 acc[4][4]; zero_acc(acc);
  gemm_core((const bf16_t*)(ws + WS_MEMB) + (size_t)m0 * DM, DM, (const bf16_t*)(ws + WS_WMEM) + (size_t)ll * 512 * 1024 + (size_t)n0 * DM, DM, 16, acc, lds);
  bf16_t* O = (bf16_t*)(ws + WS_MEMKV) + (size_t)ll * 2048 * 512;
#pragma unroll
  for (int i = 0; i < 4; ++i) {
    bf16_t* rowp = O + (size_t)(m0 + wm * 64 + 16 * i + q) * 512 + n0 + wn * 64 + 4 * g;
#pragma unroll
    for (int j = 0; j < 4; ++j) { u32x2 w; w.x = pk2(acc[j][i][0], acc[j][i][1]); w.y = pk2(acc[j][i][2], acc[j][i][3]); *(u32x2*)(rowp + 16 * j) = w; }
  }
}

typedef short v4i16_t __attribute__((ext_vector_type(4)));
template <int NDT>
DEVI void attn_stage(const bf16_t* Kb, size_t kstride, const bf16_t* Vb, size_t vstride, int kpos0, char* Kl, char* Vl) {
  int tid = threadIdx.x; asm volatile("" : "+v"(tid));
  const int lane = tid & 63, wave = tid >> 6;
#pragma unroll
  for (int i = 0; i < 2; ++i) {
    const int key = 8 * (4 * i + wave) + (lane >> 3), ch = (lane & 7) ^ (lane >> 3);
    __builtin_amdgcn_global_load_lds((const unsigned*)(Kb + (ptrdiff_t)(kpos0 + key) * (ptrdiff_t)kstride + ch * 8), (unsigned*)(Kl + (4 * i + wave) * 1024), 16, 0, 0);
  }
  if (NDT == 4) {
#pragma unroll
    for (int i = 0; i < 2; ++i) {
      const int key = 8 * (4 * i + wave) + (lane >> 3), cp = lane & 7;
      const int cl = ((((cp >> 1) ^ ((key >> 1) & 3)) << 1) | (cp & 1));
      __builtin_amdgcn_global_load_lds((const unsigned*)(Vb + (ptrdiff_t)(kpos0 + key) * (ptrdiff_t)vstride + cl * 8), (unsigned*)(Vl + (4 * i + wave) * 1024), 16, 0, 0);
    }
  } else {
#pragma unroll
    for (int i = 0; i < 4; ++i) {
      const int key = 4 * (4 * i + wave) + (lane >> 4), cp = lane & 15;
      const int cl = ((((cp >> 1) ^ (key & 7)) << 1) | (cp & 1));
      __builtin_amdgcn_global_load_lds((const unsigned*)(Vb + (ptrdiff_t)(kpos0 + key) * (ptrdiff_t)vstride + cl * 8), (unsigned*)(Vl + (4 * i + wave) * 1024), 16, 0, 0);
    }
  }
}

template <int NDT, int NQS, bool HASTAB, int RING>
DEVI void attn_pass(const bf16_t* Qb, size_t qstride, const bf16_t* Kb, size_t kstride, const bf16_t* Vb, size_t vstride,
                    int kt_lo, int kt_hi, int kbase, int qpos0, const float* tab, int tab_off, char* lds,
                    f32x4 (&o)[NDT][NQS], float (&m_run)[NQS], float (&l_run)[NQS]) {
  int tid_ = threadIdx.x; asm volatile("" : "+v"(tid_));
  const int lane = tid_ & 63, wave = tid_ >> 6, q = lane & 15, g = lane >> 4;
  const int qw = wave * 16 * NQS;
  constexpr int VB_BYTES = NDT * 2048, ROWB = NDT * 32;
  static_assert(RING == 2 || RING == 3, "ring depth");
  char* Kl = lds; char* Vl = lds + RING * 8192;
  bf16x8 qf[NQS][2];
#pragma unroll
  for (int qs = 0; qs < NQS; ++qs)
#pragma unroll
    for (int ks = 0; ks < 2; ++ks) qf[qs][ks] = *(const bf16x8*)(Qb + (size_t)(qw + 16 * qs + q) * qstride + 32 * ks + 8 * g);
#pragma unroll
  for (int dt = 0; dt < NDT; ++dt)
#pragma unroll
    for (int qs = 0; qs < NQS; ++qs) o[dt][qs] = (f32x4){0.f, 0.f, 0.f, 0.f};
#pragma unroll
  for (int qs = 0; qs < NQS; ++qs) { m_run[qs] = NEGBIG; l_run[qs] = 0.f; }
  const float sc = 0.125f * LOG2E;
  const int n = kt_hi - kt_lo;
  attn_stage<NDT>(Kb, kstride, Vb, vstride, kbase + 64 * kt_lo, Kl, Vl);
  if (RING == 3) {
    if (n > 1) { attn_stage<NDT>(Kb, kstride, Vb, vstride, kbase + 64 * (kt_lo + 1), Kl + 8192, Vl + VB_BYTES); if (NDT == 4) ATTN_WAIT_BARRIER(4); else ATTN_WAIT_BARRIER(6); }
    else ATTN_WAIT_BARRIER(0);
  } else ATTN_WAIT_BARRIER(0);
  const int frow = q * 128, fx = lane & 7;
  const int qq = q >> 2, pp = lane & 3;
  const int vrow = 4 * g + qq;
  const int vsw = (NDT == 4) ? ((vrow >> 1) & 3) : (vrow & 7);
  const int vbase = vrow * ROWB + 8 * pp;
  int slot = 0;
  for (int i = 0; i < n; ++i) {
    if (i + RING - 1 < n) {
      int ns = slot + RING - 1; if (ns >= RING) ns -= RING;
      attn_stage<NDT>(Kb, kstride, Vb, vstride, kbase + 64 * (kt_lo + i + RING - 1), Kl + ns * 8192, Vl + ns * VB_BYTES);
    }
    const int kt = kt_lo + i;
    const char* Kc = Kl + slot * 8192 + frow;
    const char* Vc = Vl + slot * VB_BYTES + vbase;
    f32x4 s[4][NQS];
#pragma unroll
    for (int k4 = 0; k4 < 4; ++k4)
#pragma unroll
      for (int qs = 0; qs < NQS; ++qs) s[k4][qs] = (f32x4){0.f, 0.f, 0.f, 0.f};
#pragma unroll
    for (int ks = 0; ks < 2; ++ks) {
      const int co = ((4 * ks + g) ^ fx) << 4;
#pragma unroll
      for (int k4 = 0; k4 < 4; ++k4) {
        const bf16x8 kf = *(const bf16x8*)(Kc + k4 * 2048 + co);
#pragma unroll
        for (int qs = 0; qs < NQS; ++qs) s[k4][qs] = mfma16(kf, qf[qs][ks], s[k4][qs]);
      }
    }
    bf16x8 pf[NQS][2];
#pragma unroll
    for (int qs = 0; qs < NQS; ++qs) {
      float tm = NEGBIG;
      if (HASTAB) {
        const float* tp = tab + (kbase + 64 * kt + 4 * g) - (qpos0 + qw + 16 * qs + q) + tab_off;
#pragma unroll
        for (int k4 = 0; k4 < 4; ++k4)
#pragma unroll
          for (int r = 0; r < 4; ++r) { const float x = s[k4][qs][r] * sc + tp[16 * k4 + r]; s[k4][qs][r] = x; tm = fmaxf(tm, x); }
      } else {
#pragma unroll
        for (int k4 = 0; k4 < 4; ++k4)
#pragma unroll
          for (int r = 0; r < 4; ++r) { const float x = s[k4][qs][r] * sc; s[k4][qs][r] = x; tm = fmaxf(tm, x); }
      }
      tm = fmaxf(tm, __shfl_xor(tm, 16)); tm = fmaxf(tm, __shfl_xor(tm, 32));
      const float mn = fmaxf(m_run[qs], tm);
      const float alpha = __builtin_amdgcn_exp2f(m_run[qs] - mn);
      m_run[qs] = mn;
      float ls = 0.f;
#pragma unroll
      for (int k4 = 0; k4 < 4; ++k4)
#pragma unroll
        for (int r = 0; r < 4; ++r) { const float pv = __builtin_amdgcn_exp2f(s[k4][qs][r] - mn); s[k4][qs][r] = pv; ls += pv; }
      l_run[qs] = l_run[qs] * alpha + ls;
      if (__builtin_amdgcn_ballot_w64(alpha != 1.f) != 0ull) {
#pragma unroll
        for (int dt = 0; dt < NDT; ++dt) o[dt][qs] = o[dt][qs] * alpha;
      }
#pragma unroll
      for (int kb = 0; kb < 2; ++kb) {
        u32x4 w;
        w.x = pk2(s[2 * kb][qs][0], s[2 * kb][qs][1]); w.y = pk2(s[2 * kb][qs][2], s[2 * kb][qs][3]);
        w.z = pk2(s[2 * kb + 1][qs][0], s[2 * kb + 1][qs][1]); w.w = pk2(s[2 * kb + 1][qs][2], s[2 * kb + 1][qs][3]);
        pf[qs][kb] = __builtin_bit_cast(bf16x8, w);
      }
    }
#pragma unroll
    for (int kb = 0; kb < 2; ++kb) {
#pragma unroll
      for (int dt = 0; dt < NDT; ++dt) {
        const char* vp = Vc + (32 * kb) * ROWB + ((dt ^ vsw) << 5);
        const v4i16_t v0 = __builtin_amdgcn_ds_read_tr16_b64_v4i16((__attribute__((address_space(3))) v4i16_t*)vp);
        const v4i16_t v1 = __builtin_amdgcn_ds_read_tr16_b64_v4i16((__attribute__((address_space(3))) v4i16_t*)(vp + 16 * ROWB));
        bf16x8 vf; vf[0] = v0[0]; vf[1] = v0[1]; vf[2] = v0[2]; vf[3] = v0[3]; vf[4] = v1[0]; vf[5] = v1[1]; vf[6] = v1[2]; vf[7] = v1[3];
#pragma unroll
        for (int qs = 0; qs < NQS; ++qs) o[dt][qs] = mfma16(vf, pf[qs][kb], o[dt][qs]);
      }
    }
    if (RING == 3 && i + 2 < n) { if (NDT == 4) ATTN_WAIT_BARRIER(4); else ATTN_WAIT_BARRIER(6); }
    else ATTN_WAIT_BARRIER(0);
    ++slot; if (slot >= RING) slot = 0;
  }
#pragma unroll
  for (int qs = 0; qs < NQS; ++qs) { float l = l_run[qs]; l += __shfl_xor(l, 16); l += __shfl_xor(l, 32); l_run[qs] = l; }
}

DEVI void attn_tile_CM(const Params& p, int l, int c, int tile, bool isM, char* lds, int dry) {
  unsigned char* ws = p.ws;
  LAUNDER_GP(ws);
  bf16_t* P = (bf16_t*)(ws + WS_P);
  int tid_ = threadIdx.x; asm volatile("" : "+v"(tid_));
  const int lane = tid_ & 63, wave = tid_ >> 6, q = lane & 15, g = lane >> 4;
  f32x4 o[4][2]; float m_run[2], l_run[2];
  int b, h, qt, gcol;
  if (!isM) {
    b = tile >> 7; h = (tile >> 4) & 7; qt = tile & 15; gcol = C_G + 64 * h;
    const bf16_t* base = P + (size_t)(b * S) * PC;
    attn_pass<4, 2, false, 3>(base + (size_t)(128 * qt) * PC + C_Q + 64 * h, PC, base + C_K + 64 * (h >> 2), PC, base + C_V + 64 * (h >> 2), PC,
                           0, 32, 0, 128 * qt, nullptr, 0, lds, o, m_run, l_run);
  } else {
    b = tile >> 6; h = (tile >> 4) & 3; qt = tile & 15; gcol = M_G + 64 * h;
    const bf16_t* base = P + (size_t)(b * S) * PC;
    const bf16_t* kv = (const bf16_t*)(ws + WS_MEMKV) + (size_t)l * 2048 * 512 + (size_t)((c * NB + b) * NMEM) * 512;
    attn_pass<4, 2, false, 3>(base + (size_t)(128 * qt) * PC + M_Q + 64 * h, PC, kv + 64 * h, 512, kv + 256 + 64 * h, 512,
                           0, 4, 0, 128 * qt, nullptr, 0, lds, o, m_run, l_run);
  }
#pragma unroll
  for (int qs = 0; qs < 2; ++qs) {
    const float inv = 1.f / l_run[qs];
    bf16_t* rowp = P + (size_t)(b * S + 128 * qt + wave * 32 + 16 * qs + q) * PC + gcol + 4 * g;
#pragma unroll
    for (int dt = 0; dt < 4; ++dt) {
      const u32x2 gt = *(const u32x2*)(rowp + 16 * dt);
      u32x2 w;
      w.x = pk2(o[dt][qs][0] * inv * silu_f(bflo(gt.x)), o[dt][qs][1] * inv * silu_f(bfhi(gt.x)));
      w.y = pk2(o[dt][qs][2] * inv * silu_f(bflo(gt.y)), o[dt][qs][3] * inv * silu_f(bfhi(gt.y)));
      if (!dry) *(u32x2*)(rowp + 16 * dt) = w;
    }
  }
}

DEVI void attn_tile_D(const Params& p, int l, int c, int tile, char* lds, int dry) {
  unsigned char* ws = p.ws;
  LAUNDER_GP(ws);
  bf16_t* P = (bf16_t*)(ws + WS_P);
  const float* tabg = (const float*)(ws + WS_TAB);
  int tid = threadIdx.x; asm volatile("" : "+v"(tid));
  const int lane = tid & 63, wave = tid >> 6, q = lane & 15, g = lane >> 4;
  const int b = tile >> 7, h = (tile >> 5) & 3, qt = tile & 31;
  float* tl = (float*)(lds + 65536);
  for (int i = tid; i < 1408; i += 256) tl[i] = tabg[TB_BD + h * 4096 + (i - 703 + 2047)];
  const float bias_neg = tabg[TB_BD + h * 4096 + 2047 - 1000], bias_pos = tabg[TB_BD + h * 4096 + 2047 + 1000];
  __syncthreads();
  const bf16_t* base = P + (size_t)(b * S) * PC;
  const bf16_t* Kb = base + D_K + 128 * h;
  const bf16_t* Vb = base + D_V + 128 * h;
  const int qrow = 64 * qt + wave * 16 + q;
  const float lam = tabg[TB_LAM + l];
  const float lam_init = 0.8f - 0.6f * __expf(-0.3f * (float)l);
  bf16x8 qf[2][2];
#pragma unroll
  for (int mp = 0; mp < 2; ++mp)
#pragma unroll
    for (int ks = 0; ks < 2; ++ks) qf[mp][ks] = *(const bf16x8*)(base + (size_t)qrow * PC + D_Q + 128 * h + 64 * mp + 32 * ks + 8 * g);
  f32x4 o[2][8];
#pragma unroll
  for (int mp = 0; mp < 2; ++mp)
#pragma unroll
    for (int dt = 0; dt < 8; ++dt) o[mp][dt] = (f32x4){0.f, 0.f, 0.f, 0.f};
  float m_run[2] = {NEGBIG, NEGBIG}, l_run[2] = {0.f, 0.f};
  const float sc = 0.125f * LOG2E;
  auto stage = [&](int kt, int slot) {
    char* Kl = lds + slot * 16384; char* Vl = lds + 32768 + slot * 16384;
#pragma unroll
    for (int i = 0; i < 4; ++i) {
      const int key = 4 * (4 * i + wave) + (lane >> 4), cp = lane & 15;
      const int ck = cp ^ (key & 15);
      __builtin_amdgcn_global_load_lds((const unsigned*)(Kb + (size_t)(64 * kt + key) * PC + ck * 8), (unsigned*)(Kl + (4 * i + wave) * 1024), 16, 0, 0);
      const int cv = ((((cp >> 1) ^ (key & 7)) << 1) | (cp & 1));
      __builtin_amdgcn_global_load_lds((const unsigned*)(Vb + (size_t)(64 * kt + key) * PC + cv * 8), (unsigned*)(Vl + (4 * i + wave) * 1024), 16, 0, 0);
    }
  };
  stage(0, 0);
  ATTN_WAIT_BARRIER(0);
  const int qq = q >> 2, pp = lane & 3, vrow = 4 * g + qq, vsw = vrow & 7, vbase = vrow * 256 + 8 * pp;
  for (int kt = 0; kt < 32; ++kt) {
    const int slot = kt & 1;
    if (kt + 1 < 32) stage(kt + 1, slot ^ 1);
    const char* Kc = lds + slot * 16384 + q * 256;
    const char* Vc = lds + 32768 + slot * 16384 + vbase;
    f32x4 s[2][4];
#pragma unroll
    for (int mp = 0; mp < 2; ++mp)
#pragma unroll
      for (int k4 = 0; k4 < 4; ++k4) s[mp][k4] = (f32x4){0.f, 0.f, 0.f, 0.f};
#pragma unroll
    for (int mp = 0; mp < 2; ++mp)
#pragma unroll
      for (int ks = 0; ks < 2; ++ks) {
        const int co = ((8 * mp + 4 * ks + g) ^ q) << 4;
#pragma unroll
        for (int k4 = 0; k4 < 4; ++k4) s[mp][k4] = mfma16(*(const bf16x8*)(Kc + k4 * 4096 + co), qf[mp][ks], s[mp][k4]);
      }
    f32x4 bs[4];
    const int d0 = 64 * kt - 64 * qt;
    if (d0 - 63 >= 559 || d0 + 63 <= -559) {
      const float bc = (d0 > 0) ? bias_pos : bias_neg;
#pragma unroll
      for (int k4 = 0; k4 < 4; ++k4) bs[k4] = (f32x4){bc, bc, bc, bc};
    } else {
      const float* tp = tl + (64 * kt + 4 * g) - qrow + 703;
#pragma unroll
      for (int k4 = 0; k4 < 4; ++k4)
#pragma unroll
        for (int r = 0; r < 4; ++r) bs[k4][r] = tp[16 * k4 + r];
    }
    bf16x8 pf[2][2];
#pragma unroll
    for (int mp = 0; mp < 2; ++mp) {
      float tm = NEGBIG;
#pragma unroll
      for (int k4 = 0; k4 < 4; ++k4)
#pragma unroll
        for (int r = 0; r < 4; ++r) { const float x = s[mp][k4][r] * sc + bs[k4][r]; s[mp][k4][r] = x; tm = fmaxf(tm, x); }
      tm = fmaxf(tm, __shfl_xor(tm, 16)); tm = fmaxf(tm, __shfl_xor(tm, 32));
      const float mn = fmaxf(m_run[mp], tm);
      const float alpha = __builtin_amdgcn_exp2f(m_run[mp] - mn);
      m_run[mp] = mn;
      float ls = 0.f;
#pragma unroll
      for (int k4 = 0; k4 < 4; ++k4)
#pragma unroll
        for (int r = 0; r < 4; ++r) { const float pv = __builtin_amdgcn_exp2f(s[mp][k4][r] - mn); s[mp][k4][r] = pv; ls += pv; }
      l_run[mp] = l_run[mp] * alpha + ls;
      if (__builtin_amdgcn_ballot_w64(alpha != 1.f) != 0ull) {
#pragma unroll
        for (int dt = 0; dt < 8; ++dt) o[mp][dt] = o[mp][dt] * alpha;
      }
#pragma unroll
      for (int kb = 0; kb < 2; ++kb) {
        u32x4 w;
        w.x = pk2(s[mp][2 * kb][0], s[mp][2 * kb][1]); w.y = pk2(s[mp][2 * kb][2], s[mp][2 * kb][3]);
        w.z = pk2(s[mp][2 * kb + 1][0], s[mp][2 * kb + 1][1]); w.w = pk2(s[mp][2 * kb + 1][2], s[mp][2 * kb + 1][3]);
        pf[mp][kb] = __builtin_bit_cast(bf16x8, w);
      }
    }
#pragma unroll
    for (int kb = 0; kb < 2; ++kb)
#pragma unroll
      for (int dt = 0; dt < 8; ++dt) {
        const char* vp = Vc + (32 * kb) * 256 + ((dt ^ vsw) << 5);
        const v4i16_t v0 = __builtin_amdgcn_ds_read_tr16_b64_v4i16((__attribute__((address_space(3))) v4i16_t*)vp);
        const v4i16_t v1 = __builtin_amdgcn_ds_read_tr16_b64_v4i16((__attribute__((address_space(3))) v4i16_t*)(vp + 16 * 256));
        bf16x8 vf; vf[0] = v0[0]; vf[1] = v0[1]; vf[2] = v0[2]; vf[3] = v0[3]; vf[4] = v1[0]; vf[5] = v1[1]; vf[6] = v1[2]; vf[7] = v1[3];
        o[0][dt] = mfma16(vf, pf[0][kb], o[0][dt]);
        o[1][dt] = mfma16(vf, pf[1][kb], o[1][dt]);
      }
    ATTN_WAIT_BARRIER(0);
  }
#pragma unroll
  for (int mp = 0; mp < 2; ++mp) { float lsum = l_run[mp]; lsum += __shfl_xor(lsum, 16); lsum += __shfl_xor(lsum, 32); l_run[mp] = lsum; }
  const float* sg = p.in[19] + (size_t)l * 128;
  {
    const float i1 = rcp_f(l_run[0]), i2 = lam * rcp_f(l_run[1]);
    float ss = 0.f;
#pragma unroll
    for (int dt = 0; dt < 8; ++dt) {
      o[0][dt] = o[0][dt] * i1 - o[1][dt] * i2;
#pragma unroll
      for (int r = 0; r < 4; ++r) ss += o[0][dt][r] * o[0][dt][r];
    }
    ss += __shfl_xor(ss, 16); ss += __shfl_xor(ss, 32);
    const float rs = rsqrtf(ss * (1.f / 128.f) + 1e-5f) * (1.f - lam_init);
    bf16_t* rowp = P + (size_t)(b * S + qrow) * PC + D_G + 128 * h + 4 * g;
#pragma unroll
    for (int dt = 0; dt < 8; ++dt) {
      const u32x2 gt = *(const u32x2*)(rowp + 16 * dt);
      const f32x4 sgv = *(const f32x4*)(sg + 16 * dt + 4 * g);
      u32x2 w;
      w.x = pk2(o[0][dt][0] * rs * sgv[0] * silu_f(bflo(gt.x)), o[0][dt][1] * rs * sgv[1] * silu_f(bfhi(gt.x)));
      w.y = pk2(o[0][dt][2] * rs * sgv[2] * silu_f(bflo(gt.y)), o[0][dt][3] * rs * sgv[3] * silu_f(bfhi(gt.y)));
      if (!dry) *(u32x2*)(rowp + 16 * dt) = w;
    }
  }
}

DEVI void attn_tile_A(const Params& p, int l, int c, int tile, char* lds) {
  unsigned char* ws = p.ws;
  LAUNDER_GP(ws);
  bf16_t* P = (bf16_t*)(ws + WS_P);
  const float* tabg = (const float*)(ws + WS_TAB);
  int tid = threadIdx.x; asm volatile("" : "+v"(tid));
  const int lane = tid & 63, wave = tid >> 6, q = lane & 15, g = lane >> 4;
  const int gi = tile >> 9, idx = tile & 511, b = idx >> 7, h = (idx >> 4) & 7, rn = idx & 15;
  const int dsh = 2 * gi, dil = 1 << dsh, nb2 = 16 >> dsh;
  const int r = rn / nb2, n2 = rn - r * nb2;
  float* tl = (float*)(lds + 49152);
  for (int i = tid; i < 384; i += 256) tl[i] = tabg[TB_BA2 + (gi * 8 + h) * 384 + i];
  __syncthreads();
  const bf16_t* base = P + (size_t)(b * S + r) * PC;
  const size_t st = (size_t)dil * PC;
  f32x4 o[4][2]; float m_run[2], l_run[2];
  const int kt_lo = (n2 == 0) ? 1 : 0, kt_hi = (n2 == nb2 - 1) ? 3 : 4;
  attn_pass<4, 2, true, 3>(base + (size_t)(128 * n2) * st + A_Q + 64 * h, st, base + A_K + 64 * h, st, base + A_V + 64 * h, st,
                           kt_lo, kt_hi, 128 * n2 - 64, 128 * n2, tl, 192, lds, o, m_run, l_run);
  bf16_t* AT = (bf16_t*)(ws + WS_AT) + (size_t)gi * TC * 512;
  float* LSE = (float*)(ws + WS_LSE) + (size_t)gi * TC * 8;
#pragma unroll
  for (int qs = 0; qs < 2; ++qs) {
    const int ell = 128 * n2 + wave * 32 + 16 * qs + q;
    const size_t tok = (size_t)(b * S) + (size_t)ell * dil + r;
    const float inv = rcp_f(l_run[qs]);
#pragma unroll
    for (int dt = 0; dt < 4; ++dt) {
      u32x2 w; w.x = pk2(o[dt][qs][0] * inv, o[dt][qs][1] * inv); w.y = pk2(o[dt][qs][2] * inv, o[dt][qs][3] * inv);
      *(u32x2*)(AT + tok * 512 + 64 * h + 16 * dt + 4 * g) = w;
    }
    if (g == 0) LSE[tok * 8 + h] = m_run[qs] + log2f(l_run[qs]);
  }
}

DEVI bf16x8 frag_lo(const f32x4 v) { u32x4 w; w.x = pk2(v[0], v[1]); w.y = pk2(v[2], v[3]); w.z = 0u; w.w = 0u; return __builtin_bit_cast(bf16x8, w); }
DEVI void scan_item(const Params& p, int l, int c, int item, char* lds) {
  unsigned char* ws = p.ws;
  LAUNDER_GP(ws);
  const bf16_t* P = (const bf16_t*)(ws + WS_P);
  int tid = threadIdx.x; asm volatile("" : "+v"(tid));
  const int lane = tid & 63, wave = tid >> 6, q = lane & 15, g = lane >> 4;
  const int e = item & 1, h = (item >> 1) & 7, b = item >> 4;
  const int ul = tid >> 4, cg = tid & 15;
  constexpr int STGB = 10240, IMGB = 17664;
  char* IMG0 = lds + 2 * STGB;
  float* MU = (float*)(lds + 2 * STGB + 2 * IMGB);
  for (int i = tid; i < 512; i += 256) { char* ib = IMG0 + (i >> 8) * IMGB; ((unsigned*)(ib + 12288))[i & 255] = 0u; ((unsigned*)(ib + 14336))[i & 255] = 0u; }
  const f32x4 k_k = *(const f32x4*)(p.in[11] + (size_t)l * 512 + 64 * h + 4 * cg);
  const int cl = 16 * wave + q;
  constexpr float LOG2E = 1.44269504088896341f;
  const float w0c2 = -LOG2E * p.in[7][(size_t)l * 1024 + e * 512 + 64 * h + cl];
  const float a0c2 = -LOG2E * p.in[9][(size_t)l * 1024 + e * 512 + 64 * h + cl];
  const float k_ac = p.in[12][(size_t)l * 512 + 64 * h + cl];
  const float r_kc = p.in[13][(size_t)l * 512 + 64 * h + cl];
  bf16x8 wuf[2], auf[2];
  {
    const float* wup = p.in[8] + (size_t)l * 2 * 64 * 512 + (size_t)e * 64 * 512 + 64 * h + 16 * wave + q;
    const float* aup = p.in[10] + (size_t)l * 2 * 64 * 512 + (size_t)e * 64 * 512 + 64 * h + 16 * wave + q;
#pragma unroll
    for (int ks = 0; ks < 2; ++ks) {
      u32x4 w, a;
#pragma unroll
      for (int jj = 0; jj < 4; ++jj) {
        const int rho = 32 * ks + 8 * g + 2 * jj;
        w[jj] = pk2(wup[(size_t)rho * 512], wup[(size_t)(rho + 1) * 512]);
        a[jj] = pk2(aup[(size_t)rho * 512], aup[(size_t)(rho + 1) * 512]);
      }
      wuf[ks] = __builtin_bit_cast(bf16x8, w); auf[ks] = __builtin_bit_cast(bf16x8, a);
    }
  }
  const bf16_t* Pb = P + (size_t)(b * S) * PC;
  bf16_t* YS = (bf16_t*)(ws + WS_YS) + (size_t)e * TC * 512 + (size_t)(b * S) * 512 + 64 * h + 16 * wave + q;
  float* BONP = (float*)(ws + WS_BONP) + (size_t)e * TC * 32 + (size_t)(b * S) * 32 + h * 4 + wave;
  f32x4 ST[4];
#pragma unroll
  for (int jt = 0; jt < 4; ++jt) ST[jt] = (f32x4){0.f, 0.f, 0.f, 0.f};
  {
    const float* mu = p.in[6] + (size_t)l * 2 * 1792;
    for (int i = tid; i < 640; i += 256) {
      const int s2 = i / 320, j = i - s2 * 320, seg = j >> 6, ch = j & 63;
      const int col = (seg == 0 ? 0 : seg == 1 ? 512 : seg == 2 ? 1024 : seg == 3 ? 1536 : 1664) + (seg < 3 ? 64 * h : 64 * e) + ch;
      MU[i] = mu[s2 * 1792 + col];
    }
  }
  __syncthreads();
  const int tl_ = (e == 0) ? ul : (15 - ul);
  const int pB = 32 * (cl >> 5) + 8 * ((cl >> 2) & 3) + 4 * ((cl >> 4) & 1) + (cl & 3);
  u32x2 pre[2][15];
  auto issue_loads = [&](int chunk, int sl) {
    const int t = ((e == 0) ? 16 * chunk : (S - 16 - 16 * chunk)) + tl_;
    const int tm = t > 0 ? t - 1 : 0, tp = t < S - 1 ? t + 1 : S - 1;
#pragma unroll
    for (int seg = 0; seg < 5; ++seg) {
      const int col = (seg == 0 ? B_R : seg == 1 ? B_K : seg == 2 ? B_V : seg == 3 ? B_WD : B_AD) + (seg < 3 ? 64 * h : 64 * e) + 4 * cg;
      pre[sl][3 * seg + 1] = *(const u32x2*)(Pb + (size_t)t * PC + col);
      pre[sl][3 * seg + 0] = *(const u32x2*)(Pb + (size_t)tm * PC + col);
      pre[sl][3 * seg + 2] = *(const u32x2*)(Pb + (size_t)tp * PC + col);
    }
  };
  float xv[2][4];
  auto stage1 = [&](int ch, int sl) {
    char* sb = lds + sl * STGB;
    const int t = ((e == 0) ? 16 * ch : (S - 16 - 16 * ch)) + tl_;
    const float zm = (t > 0) ? 1.f : 0.f, zp = (t < S - 1) ? 1.f : 0.f;
    float xs[5][4];
#pragma unroll
    for (int seg = 0; seg < 5; ++seg) {
      const u32x2 cm = pre[sl][3 * seg], c0 = pre[sl][3 * seg + 1], cp = pre[sl][3 * seg + 2];
      const float x0[4] = {bflo(c0.x), bfhi(c0.x), bflo(c0.y), bfhi(c0.y)};
      const float xm[4] = {bflo(cm.x) * zm, bfhi(cm.x) * zm, bflo(cm.y) * zm, bfhi(cm.y) * zm};
      const float xp[4] = {bflo(cp.x) * zp, bfhi(cp.x) * zp, bflo(cp.y) * zp, bfhi(cp.y) * zp};
      const f32x4 m0 = *(const f32x4*)(MU + 64 * seg + 4 * cg), m1 = *(const f32x4*)(MU + 320 + 64 * seg + 4 * cg);
#pragma unroll
      for (int j = 0; j < 4; ++j) xs[seg][j] = x0[j] + m0[j] * (xm[j] - x0[j]) + m1[j] * (xp[j] - x0[j]);
    }
    float th[4];
#pragma unroll
    for (int j = 0; j < 4; ++j) th[j] = 1.f - 2.f * rcp_f(1.f + __expf(2.f * xs[3][j]));
    u32x2 w; w.x = pk2(th[0], th[1]); w.y = pk2(th[2], th[3]);
    *(u32x2*)(sb + (ul * 64 + 4 * cg) * 2) = w;
    u32x2 a; a.x = pk2(xs[4][0], xs[4][1]); a.y = pk2(xs[4][2], xs[4][3]);
    *(u32x2*)(sb + 2048 + (ul * 64 + 4 * cg) * 2) = a;
    f32x4 kk; float ss = 0.f;
#pragma unroll
    for (int j = 0; j < 4; ++j) { kk[j] = xs[1][j] * k_k[j]; ss += kk[j] * kk[j]; xv[sl][j] = xs[2][j]; }
    ss = row16_sum(ss);
    kk = kk * rcp_f(fmaxf(sqrtf(ss), 1e-12f));
    u32x2 wr; wr.x = pk2(xs[0][0], xs[0][1]); wr.y = pk2(xs[0][2], xs[0][3]);
    u32x2 wk; wk.x = pk2(xs[1][0], xs[1][1]); wk.y = pk2(xs[1][2], xs[1][3]);
    u32x2 wkk; wkk.x = pk2(kk[0], kk[1]); wkk.y = pk2(kk[2], kk[3]);
    *(u32x2*)(sb + 4096 + (ul * 64 + 4 * cg) * 2) = wr;
    *(u32x2*)(sb + 6144 + (ul * 64 + 4 * cg) * 2) = wk;
    *(u32x2*)(sb + 8192 + (ul * 64 + 4 * cg) * 2) = wkk;
  };
  auto stage2 = [&](int ch, int sl) {
    const char* sb = lds + sl * STGB; char* ib = IMG0 + sl * IMGB;
    const bf16_t* LAw = (const bf16_t*)sb; const bf16_t* LAa = (const bf16_t*)(sb + 2048);
    const bf16_t* XR = (const bf16_t*)(sb + 4096); const bf16_t* XK = (const bf16_t*)(sb + 6144); const bf16_t* XKK = (const bf16_t*)(sb + 8192);
    const int tlo = (e == 0) ? 16 * ch : (S - 16 - 16 * ch);
    char* AT = ib; char* RT = ib + 2048; char* BT = ib + 4096; char* KT = ib + 6144; char* BK = ib + 8192; char* VI = ib + 15360; float* GC = (float*)(ib + 17408);
#pragma unroll
    for (int j = 0; j < 4; ++j) *(bf16_t*)(VI + (4 * cg + j) * 32 + ul * 2) = (bf16_t)(pk2(xv[sl][j], 0.f) & 0xffffu);
    f32x4 aw = (f32x4){0.f, 0.f, 0.f, 0.f}, aa = aw;
#pragma unroll
    for (int ks = 0; ks < 2; ++ks) {
      const bf16x8 fw = *(const bf16x8*)(LAw + q * 64 + 32 * ks + 8 * g);
      const bf16x8 fa = *(const bf16x8*)(LAa + q * 64 + 32 * ks + 8 * g);
      aw = mfma16(fw, wuf[ks], aw); aa = mfma16(fa, auf[ks], aa);
    }
    float lw[4], G[4], av[4], bv[4], kv[4], rv[4], bo[4];
#pragma unroll
    for (int r = 0; r < 4; ++r) {
      const int tau = 4 * g + r;
      const float rr = bf1(XR[tau * 64 + cl]), kx = bf1(XK[tau * 64 + cl]), kkx = bf1(XKK[tau * 64 + cl]);
      lw[r] = (-0.60653065971263342f * LOG2E) * rcp_f(1.f + __builtin_amdgcn_exp2f(__builtin_fmaf(aw[r], -LOG2E, w0c2)));
      const float asg = rcp_f(1.f + __builtin_amdgcn_exp2f(__builtin_fmaf(aa[r], -LOG2E, a0c2)));
      const float ke = kx * (1.f + (asg - 1.f) * k_ac);
      av[r] = -kkx; bv[r] = kkx * asg; kv[r] = ke; rv[r] = rr;
      bo[r] = rr * ke * r_kc;
    }
    G[0] = lw[0]; G[1] = G[0] + lw[1]; G[2] = G[1] + lw[2]; G[3] = G[2] + lw[3];
    float t2 = G[3];
    { float x = __shfl_up(t2, 16); if (lane >= 16) t2 += x; x = __shfl_up(t2, 32); if (lane >= 32) t2 += x; }
    const float offs = t2 - G[3];
    const float Ga = __shfl(t2, q + 48);
    const float gC = __builtin_amdgcn_exp2f(Ga);
    float bh[4], kh[4];
#pragma unroll
    for (int r = 0; r < 4; ++r) {
      const int tau = 4 * g + r;
      const float Gr = G[r] + offs;
      const float eG = __builtin_amdgcn_exp2f(Gr), eGm1 = __builtin_amdgcn_exp2f(Gr - lw[r]), enG = __builtin_amdgcn_exp2f(-Gr), eGC = gC * enG;
      *(bf16_t*)(AT + tau * 128 + pB * 2) = (bf16_t)(pk2(av[r] * eGm1, 0.f) & 0xffffu);
      *(bf16_t*)(RT + tau * 128 + pB * 2) = (bf16_t)(pk2(rv[r] * eG, 0.f) & 0xffffu);
      *(bf16_t*)(BT + tau * 128 + pB * 2) = (bf16_t)(pk2(bv[r] * enG, 0.f) & 0xffffu);
      *(bf16_t*)(KT + tau * 128 + pB * 2) = (bf16_t)(pk2(kv[r] * enG, 0.f) & 0xffffu);
      bh[r] = bv[r] * eGC; kh[r] = kv[r] * eGC;
      const float bs = row16_sum(bo[r]);
      if (q == 0) BONP[(size_t)(tlo + ((e == 0) ? tau : (15 - tau))) * 32] = bs;
    }
    { u32x4 w; w.x = pk2(bh[0], bh[1]); w.y = pk2(bh[2], bh[3]); w.z = pk2(kh[0], kh[1]); w.w = pk2(kh[2], kh[3]); *(u32x4*)(BK + cl * 64 + g * 16) = w; }
    if (g == 0) GC[cl] = gC;
  };
  auto stage5 = [&](char* ib, int rot) {
    const int wv = wave ^ rot;
    const char* AT = ib; const char* RT = ib + 2048; const char* BT = ib + 4096; const char* KT = ib + 6144; char* MKA = ib + 12288; char* MBK = ib + 13312; char* TTI = ib + 14336;
    const char* Aimg = (wv < 2) ? AT : RT;
    const char* Bimg = (wv & 1) ? KT : BT;
    f32x4 m = (f32x4){0.f, 0.f, 0.f, 0.f};
#pragma unroll
    for (int kb = 0; kb < 2; ++kb) m = mfma16(*(const bf16x8*)(Aimg + q * 128 + kb * 64 + g * 16), *(const bf16x8*)(Bimg + q * 128 + kb * 64 + g * 16), m);
#pragma unroll
    for (int r = 0; r < 4; ++r) { const int tau = 4 * g + r; const bool keep = (wv < 2) ? (q < tau) : (q <= tau); m[r] = keep ? m[r] : 0.f; }
    if (wv == 0) {
      f32x4 L = m, LT = (f32x4){0.f, 0.f, 0.f, 0.f};
#pragma unroll
      for (int kb = 0; kb < 2; ++kb) LT = mfma16(*(const bf16x8*)(BT + q * 128 + kb * 64 + g * 16), *(const bf16x8*)(AT + q * 128 + kb * 64 + g * 16), LT);
      f32x4 Pm, PT;
#pragma unroll
      for (int r = 0; r < 4; ++r) { const int sg = 4 * g + r; LT[r] = (sg < q) ? LT[r] : 0.f; const float id = (sg == q) ? 1.f : 0.f; Pm[r] = L[r] + id; PT[r] = LT[r] + id; }
      const f32x4 z4 = (f32x4){0.f, 0.f, 0.f, 0.f};
      const f32x4 L2 = mfma16(frag_lo(LT), frag_lo(L), z4), L2T = mfma16(frag_lo(L), frag_lo(LT), z4);
      const f32x4 P1 = mfma16(frag_lo(PT), frag_lo(L2), Pm), P1T = mfma16(frag_lo(L2), frag_lo(PT), PT);
      const f32x4 L4 = mfma16(frag_lo(L2T), frag_lo(L2), z4), L4T = mfma16(frag_lo(L2), frag_lo(L2T), z4);
      const f32x4 P2 = mfma16(frag_lo(P1T), frag_lo(L4), P1), P2T = mfma16(frag_lo(L4), frag_lo(P1T), P1T);
      const f32x4 L8 = mfma16(frag_lo(L4T), frag_lo(L4), z4);
      const f32x4 P3 = mfma16(frag_lo(P2T), frag_lo(L8), P2);
#pragma unroll
      for (int r = 0; r < 4; ++r) *(bf16_t*)(TTI + (4 * g + r) * 64 + (q >> 2) * 16 + (q & 3) * 2) = (bf16_t)(pk2(P3[r], 0.f) & 0xffffu);
    } else {
      char* img = (wv == 1) ? MKA : MBK;
      const int off = (wv == 2) ? 0 : 8;
#pragma unroll
      for (int r = 0; r < 4; ++r) *(bf16_t*)(img + (4 * g + r) * 64 + (q >> 2) * 16 + off + (q & 3) * 2) = (bf16_t)(pk2(m[r], 0.f) & 0xffffu);
    }
  };
  auto stage6 = [&](int ch, const char* ib) {
    const int tlo = (e == 0) ? 16 * ch : (S - 16 - 16 * ch);
    const char* AT = ib; const char* RT = ib + 2048; const char* BK = ib + 8192; const char* MKA = ib + 12288; const char* MBK = ib + 13312; const char* TTI = ib + 14336;
    const char* VI = ib + 15360; const float* GC = (const float*)(ib + 17408);
    const u32x2 vv = *(const u32x2*)(VI + (16 * wave + q) * 32 + g * 8);
    bf16x8 sf[2];
#pragma unroll
    for (int kb = 0; kb < 2; ++kb) {
      u32x4 w; w.x = pk2(ST[2 * kb][0], ST[2 * kb][1]); w.y = pk2(ST[2 * kb][2], ST[2 * kb][3]);
      w.z = pk2(ST[2 * kb + 1][0], ST[2 * kb + 1][1]); w.w = pk2(ST[2 * kb + 1][2], ST[2 * kb + 1][3]);
      sf[kb] = __builtin_bit_cast(bf16x8, w);
    }
    f32x4 ax = (f32x4){0.f, 0.f, 0.f, 0.f}, ay = ax;
#pragma unroll
    for (int kb = 0; kb < 2; ++kb) {
      ax = mfma16(*(const bf16x8*)(AT + q * 128 + kb * 64 + g * 16), sf[kb], ax);
      ay = mfma16(*(const bf16x8*)(RT + q * 128 + kb * 64 + g * 16), sf[kb], ay);
    }
    { u32x4 w; w.x = 0u; w.y = 0u; w.z = vv.x; w.w = vv.y; ax = mfma16(*(const bf16x8*)(MKA + q * 64 + g * 16), __builtin_bit_cast(bf16x8, w), ax); }
    const f32x4 au = mfma16(*(const bf16x8*)(TTI + q * 64 + g * 16), frag_lo(ax), (f32x4){0.f, 0.f, 0.f, 0.f});
    u32x4 uvw; uvw.x = pk2(au[0], au[1]); uvw.y = pk2(au[2], au[3]); uvw.z = vv.x; uvw.w = vv.y;
    const bf16x8 uvf = __builtin_bit_cast(bf16x8, uvw);
    ay = mfma16(*(const bf16x8*)(MBK + q * 64 + g * 16), uvf, ay);
#pragma unroll
    for (int jt = 0; jt < 4; ++jt) {
      const f32x4 gc4 = *(const f32x4*)(GC + 16 * jt + 4 * g);
      ST[jt] = mfma16(*(const bf16x8*)(BK + (16 * jt + q) * 64 + g * 16), uvf, ST[jt] * gc4);
    }
#pragma unroll
    for (int r = 0; r < 4; ++r) {
      const int tau = 4 * g + r, tok = tlo + ((e == 0) ? tau : (15 - tau));
      YS[(size_t)tok * 512] = (bf16_t)(pk2(ay[r], 0.f) & 0xffffu);
    }
  };
  issue_loads(0, 0); issue_loads(1, 1);
#pragma unroll 1
  for (int cp = 0; cp < S / 32; ++cp) {
    const int c0 = 2 * cp, c1 = 2 * cp + 1;
    stage1(c0, 0); stage1(c1, 1);
    __syncthreads();
    stage2(c0, 0); stage2(c1, 1);
    __syncthreads();
    if (c0 + 2 < S / 16) { issue_loads(c0 + 2, 0); issue_loads(c1 + 2, 1); }
    stage5(IMG0, 0); stage5(IMG0 + IMGB, 1);
    __syncthreads();
    stage6(c0, IMG0); stage6(c1, IMG0 + IMGB);
  }
  __syncthreads();
}

DEVI void ln_apply_rows_q(const Params& p, int l, int c, unsigned* qctr, char* lds) {
  volatile LAS int* s_itemp = (volatile LAS int*)(lds + LDS_CTRL + 16);
  for (;;) {
    __syncthreads();
    if (threadIdx.x == 0) *s_itemp = (int)__hip_atomic_fetch_add(qctr, 16u, __ATOMIC_RELAXED, __HIP_MEMORY_SCOPE_AGENT);
    __syncthreads();
    const int it0 = *s_itemp;
    if (it0 >= TC / 4) break;
    ln_apply_rows(p, l, c, it0, 1 << 30, it0 + 16);
  }
}

DEVI void signal_done(unsigned* c0, unsigned* c1, unsigned n) {
  asm volatile("s_waitcnt vmcnt(0)" ::: "memory");
  __syncthreads();
  if (threadIdx.x == 0 && n) {
    __builtin_amdgcn_fence(__ATOMIC_RELEASE, "agent");
    asm volatile("s_waitcnt vmcnt(0)" ::: "memory");
    __hip_atomic_fetch_add(c0, n, __ATOMIC_RELAXED, __HIP_MEMORY_SCOPE_AGENT);
    if (c1) __hip_atomic_fetch_add(c1, n, __ATOMIC_RELAXED, __HIP_MEMORY_SCOPE_AGENT);
  }
}
DEVI void signal_done_xcd(unsigned* xw, unsigned nloc, unsigned* c0, unsigned* c1, unsigned n) {
  asm volatile("s_waitcnt vmcnt(0)" ::: "memory");
  __syncthreads();
  if (threadIdx.x == 0) {
    const unsigned old = __hip_atomic_fetch_add(xw, (n << 16) | 1u, __ATOMIC_RELAXED, __HIP_MEMORY_SCOPE_AGENT);
    if ((old & 0xffffu) + 1u == nloc) {
      const unsigned tot = (old >> 16) + n;
      __builtin_amdgcn_fence(__ATOMIC_RELEASE, "agent");
      asm volatile("s_waitcnt vmcnt(0)" ::: "memory");
      __hip_atomic_fetch_add(c0, tot, __ATOMIC_RELAXED, __HIP_MEMORY_SCOPE_AGENT);
      if (c1) __hip_atomic_fetch_add(c1, tot, __ATOMIC_RELAXED, __HIP_MEMORY_SCOPE_AGENT);
    }
  }
}
DEVI void count_done(unsigned* c0, unsigned n, unsigned* c1 = nullptr) {
  asm volatile("s_waitcnt vmcnt(0)" ::: "memory");
  __syncthreads();
  if (threadIdx.x == 0 && n) {
    __hip_atomic_fetch_add(c0, n, __ATOMIC_RELAXED, __HIP_MEMORY_SCOPE_AGENT);
    if (c1) __hip_atomic_fetch_add(c1, n, __ATOMIC_RELAXED, __HIP_MEMORY_SCOPE_AGENT);
  }
}
DEVI void wait_count_flush(unsigned* ctr, unsigned target, unsigned* fl, unsigned nx) {
  if (threadIdx.x == 0) {
    unsigned sp = 0;
    while (__hip_atomic_load(ctr, __ATOMIC_RELAXED, __HIP_MEMORY_SCOPE_AGENT) < target) { __builtin_amdgcn_s_sleep(2); if (++sp > (1u << 24)) break; }
    if (__hip_atomic_load(fl + 16, __ATOMIC_RELAXED, __HIP_MEMORY_SCOPE_AGENT) < nx) {
      const unsigned xq = ((unsigned)__builtin_amdgcn_s_getreg((3 << 11) | 20) & 0xFu) & 7u;
      if (__hip_atomic_exchange(fl + xq, 1u, __ATOMIC_RELAXED, __HIP_MEMORY_SCOPE_AGENT) == 0u) {
        __builtin_amdgcn_fence(__ATOMIC_RELEASE, "agent");
        asm volatile("s_waitcnt vmcnt(0)" ::: "memory");
        __hip_atomic_fetch_add(fl + 16, 1u, __ATOMIC_RELAXED, __HIP_MEMORY_SCOPE_AGENT);
      }
      sp = 0;
      while (__hip_atomic_load(fl + 16, __ATOMIC_RELAXED, __HIP_MEMORY_SCOPE_AGENT) < nx) { __builtin_amdgcn_s_sleep(2); if (++sp > (1u << 24)) break; }
    }
    __builtin_amdgcn_fence(__ATOMIC_ACQUIRE, "agent");
    asm volatile("s_waitcnt vmcnt(0)" ::: "memory");
  }
  __syncthreads();
}
DEVI void wait_count(unsigned* ctr, unsigned target) {
  if (threadIdx.x == 0) {
    unsigned sp = 0;
    while (__hip_atomic_load(ctr, __ATOMIC_RELAXED, __HIP_MEMORY_SCOPE_AGENT) < target) { __builtin_amdgcn_s_sleep(2); if (++sp > (1u << 24)) break; }
    __builtin_amdgcn_fence(__ATOMIC_ACQUIRE, "agent");
    asm volatile("s_waitcnt vmcnt(0)" ::: "memory");
  }
  __syncthreads();
}
DEVI void phase_pm(const Params& p, int l, int c, char* lds) {
  LAUNDER_S(l); LAUNDER_S(c);
  unsigned* W = (unsigned*)(p.ws + WS_CTL) + 64 * (24 + 4 * (l * NCHUNK + c));
  unsigned* ctr = (unsigned*)(p.ws + WS_CTL) + 64 * (1 + l * NCHUNK + c);
  volatile LAS int* s_itemp = (volatile LAS int*)(lds + LDS_CTRL + 16);
  const int role = *(const volatile LAS int*)(lds + LDS_CTRL + 20);
  const int nextra = (l == 0 && c == 0) ? 128 : 0;
  constexpr int NB_T = 14 * 64, NN_T = 50 * 64;
  __syncthreads();
  if (threadIdx.x == 0) *s_itemp = (role == 0) ? (int)__hip_atomic_fetch_add(W + 48, 1u, __ATOMIC_RELAXED, __HIP_MEMORY_SCOPE_AGENT) : 64;
  __syncthreads();
  const int my_scan = *s_itemp;
  {
    unsigned nb = 0;
    for (int jb = blockIdx.x; jb < NB_T; jb += gridDim.x) { p_tile(p, l, c, jb & 63, 16 + (jb >> 6), lds); __syncthreads(); ++nb; }
    {
      const unsigned xq = ((unsigned)__builtin_amdgcn_s_getreg((3 << 11) | 20) & 0xFu) & 7u;
      const unsigned nloc_ = (unsigned)__builtin_amdgcn_readfirstlane((int)*(volatile LAS unsigned*)(lds + LDS_CTRL));
      signal_done_xcd((unsigned*)(p.ws + WS_CTL) + 7680 + 64 * (l * NCHUNK + c) + 2 * xq, nloc_, W + 16, W + 32, nb);
    }
  }
  const bool has_ln = !(l == 0 && c == 0);
  const int pl = (c == 0) ? l - 1 : l, pc = (c == 0) ? NCHUNK - 1 : c - 1;
  unsigned* cu_busy = (unsigned*)(p.ws + WS_CTL) + 16384 + *(const volatile LAS int*)(lds + LDS_CTRL + 24);
  if (my_scan < 64) {
    wait_count(W + 16, NB_T);
    if (threadIdx.x == 0) __hip_atomic_store(cu_busy, 1u, __ATOMIC_RELAXED, __HIP_MEMORY_SCOPE_AGENT);
    __builtin_amdgcn_s_setprio(1);
    scan_item(p, l, c, my_scan, lds);
    __builtin_amdgcn_s_setprio(0);
    if (threadIdx.x == 0) __hip_atomic_store(cu_busy, 0u, __ATOMIC_RELAXED, __HIP_MEMORY_SCOPE_AGENT);
  }
  unsigned nd = 0, ndd = 0;
  auto yield_to_scan = [&]() {
    __syncthreads();
    if (threadIdx.x == 0) *s_itemp = (int)__hip_atomic_load(cu_busy, __ATOMIC_RELAXED, __HIP_MEMORY_SCOPE_AGENT);
    __syncthreads();
    if (*s_itemp) {
      count_done(W + 40, ndd, W + 32); ndd = 0;
      count_done(W + 32, nd); nd = 0;
      if (has_ln) ln_apply_rows_q(p, pl, pc, W + 8, lds);
      if (threadIdx.x == 0) { unsigned sp = 0; while (__hip_atomic_load(cu_busy, __ATOMIC_RELAXED, __HIP_MEMORY_SCOPE_AGENT) != 0u) { __builtin_amdgcn_s_sleep(16); if (++sp > (1u << 20)) break; } }
      __syncthreads();
    }
  };
  {
    unsigned* Q = (unsigned*)(p.ws + WS_CTL) + 12288 + 64 * 8 * (l * NCHUNK + c);
    const unsigned myx = ((unsigned)__builtin_amdgcn_s_getreg((3 << 11) | 20) & 0xFu) & 7u;
    const int per_q = 50 * 8;
    for (int k = 0; k < 8; ++k) {
      const unsigned x = (myx + (unsigned)k) & 7u;
      const int lim = per_q + ((x == 0u) ? nextra : 0);
      for (;;) {
        yield_to_scan();
        __syncthreads();
        if (threadIdx.x == 0) *s_itemp = (int)__hip_atomic_fetch_add(Q + 64 * x, 1u, __ATOMIC_RELAXED, __HIP_MEMORY_SCOPE_AGENT);
        __syncthreads();
        const int jn = *s_itemp;
        if (jn >= lim) break;
        const int pidx = jn >> 3;
        const bool isD = jn < per_q && pidx < 16;
        if (!isD && ndd) { count_done(W + 40, ndd, W + 32); ndd = 0; }
        if (jn < per_q) {
          const int npp = pidx < 16 ? 44 + pidx : pidx < 26 ? 18 + pidx : pidx < 42 ? pidx - 26 : pidx < 46 ? pidx - 12 : 14 + pidx;
          p_tile(p, l, c, 8 * (jn & 7) + (int)x, npp, lds);
        } else memkv_tile(p, jn - per_q, lds);
        if (isD) ++ndd; else ++nd;
      }
    }
  }
  count_done(W + 40, ndd, W + 32);
  count_done(W + 32, nd);
  const unsigned nx_ = (unsigned)__builtin_amdgcn_readfirstlane((int)*(volatile LAS unsigned*)(lds + LDS_CTRL + 4));
  wait_count_flush(W + 40, 16u * 64u, (unsigned*)(p.ws + WS_CTL) + 7680 + 64 * (l * NCHUNK + c) + 40, nx_);
  bool all_p = false;
  constexpr int N_D = 512, N_C = 512, N_A = 1536, N_M = 256, N_ALL = N_D + N_C + N_A + N_M;
  for (;;) {
    __syncthreads();
    if (threadIdx.x == 0) *s_itemp = (int)atomicAdd(ctr, 1u);
    __syncthreads();
    int it = *s_itemp;
    if (it >= N_ALL) break;
    if (it >= N_D && !all_p) { wait_count_flush(W + 32, (unsigned)(NB_T + NN_T + nextra), (unsigned*)(p.ws + WS_CTL) + 7680 + 64 * (l * NCHUNK + c) + 16, nx_); all_p = true; }
    if (it < N_D) { attn_tile_D(p, l, c, it, lds, 0); continue; } it -= N_D;
    if (it < N_C) { attn_tile_CM(p, l, c, it, false, lds, 0); continue; } it -= N_C;
    if (it < N_M) { attn_tile_CM(p, l, c, it, true, lds, 0); continue; } it -= N_M;
    attn_tile_A(p, l, c, it, lds);
  }
  if (has_ln) ln_apply_rows_q(p, pl, pc, W + 8, lds);
  for (;;) {
    __syncthreads();
    if (threadIdx.x == 0) *s_itemp = (int)__hip_atomic_fetch_add(W + 48, 1u, __ATOMIC_RELAXED, __HIP_MEMORY_SCOPE_AGENT);
    __syncthreads();
    const int t = *s_itemp;
    if (t >= 64) break;
    scan_item(p, l, c, t, lds);
  }
}

DEVI void phase_finalize(const Params& p, int l, int c, char* lds, int dry = 0) {
  unsigned char* ws = p.ws;
  LAUNDER_S(l); LAUNDER_S(c); LAUNDER_GP(ws);
  int tid_ = threadIdx.x; LAUNDER_V(tid_);
  bf16_t* P = (bf16_t*)(ws + WS_P);
  const int gt = blockIdx.x * 256 + tid_, GT = gridDim.x * 256;
  {
    const bf16_t* AT = (const bf16_t*)(ws + WS_AT); const float* LSE = (const float*)(ws + WS_LSE);
    struct LA { float l0, l1, l2; u32x4 o0, o1, o2, gg; };
    auto loadA = [&](int i, LA& r) {
      const int tok = i >> 6, ch = i & 63, h = ch >> 3;
      r.l0 = LSE[(size_t)tok * 8 + h]; r.l1 = LSE[(size_t)TC * 8 + (size_t)tok * 8 + h]; r.l2 = LSE[(size_t)2 * TC * 8 + (size_t)tok * 8 + h];
      r.o0 = *(const u32x4*)(AT + (size_t)tok * 512 + 8 * ch); r.o1 = *(const u32x4*)(AT + (size_t)TC * 512 + (size_t)tok * 512 + 8 * ch);
      r.o2 = *(const u32x4*)(AT + (size_t)2 * TC * 512 + (size_t)tok * 512 + 8 * ch);
      r.gg = *(const u32x4*)(P + (size_t)tok * PC + A_G + 8 * ch);
    };
    auto doA = [&](int i, const LA& r) {
      const int tok = i >> 6, ch = i & 63;
      const float mx = fmaxf(r.l0, fmaxf(r.l1, r.l2));
      float w0 = exp2f(r.l0 - mx), w1 = exp2f(r.l1 - mx), w2 = exp2f(r.l2 - mx);
      const float inv = 1.f / (w0 + w1 + w2); w0 *= inv; w1 *= inv; w2 *= inv;
      u32x4 w;
#pragma unroll
      for (int k = 0; k < 4; ++k) {
        const float lo = (w0 * bflo(r.o0[k]) + w1 * bflo(r.o1[k]) + w2 * bflo(r.o2[k])) * silu_f(bflo(r.gg[k]));
        const float hi = (w0 * bfhi(r.o0[k]) + w1 * bfhi(r.o1[k]) + w2 * bfhi(r.o2[k])) * silu_f(bfhi(r.gg[k]));
        w[k] = pk2(lo, hi);
      }
      if (!dry) *(u32x4*)(P + (size_t)tok * PC + A_G + 8 * ch) = w;
    };
    for (int i = gt; i < TC * 64; i += 2 * GT) {
      const int i2 = i + GT; const bool two = i2 < TC * 64;
      LA ra, rb;
      loadA(i, ra); if (two) loadA(i2, rb);
      doA(i, ra); if (two) doA(i2, rb);
    }
  }
  {
    const bf16_t* YS = (const bf16_t*)(ws + WS_YS); const float* BONP = (const float*)(ws + WS_BONP);
    const float* mu = p.in[6] + (size_t)l * 2 * 1792;
    const float* lng = p.in[14] + (size_t)l * 512; const float* lnb = p.in[15] + (size_t)l * 512;
    struct LB { u32x4 yf, yb, v0, vm, vq, gg; f32x4 bp0, bp1; };
    auto loadB = [&](int i, LB& r) {
      const int tok = i >> 6, ch = i & 63, h = ch >> 3, t = tok & (S - 1);
      r.yf = *(const u32x4*)(YS + (size_t)tok * 512 + 8 * ch); r.yb = *(const u32x4*)(YS + (size_t)TC * 512 + (size_t)tok * 512 + 8 * ch);
      r.bp0 = *(const f32x4*)(BONP + ((size_t)tok * 8 + h) * 4); r.bp1 = *(const f32x4*)(BONP + (size_t)TC * 32 + ((size_t)tok * 8 + h) * 4);
      const bf16_t* vp = P + (size_t)tok * PC + B_V + 8 * ch;
      r.v0 = *(const u32x4*)vp;
      r.vm = (t > 0) ? *(const u32x4*)(vp - PC) : (u32x4){0u, 0u, 0u, 0u};
      r.vq = (t < S - 1) ? *(const u32x4*)(vp + PC) : (u32x4){0u, 0u, 0u, 0u};
      r.gg = *(const u32x4*)(P + (size_t)tok * PC + B_G + 8 * ch);
    };
    auto doB = [&](int i, const LB& r) {
      const int tok = i >> 6, ch = i & 63;
      float y[8]; float s = 0.f;
#pragma unroll
      for (int k = 0; k < 4; ++k) { y[2 * k] = bflo(r.yf[k]) + bflo(r.yb[k]); y[2 * k + 1] = bfhi(r.yf[k]) + bfhi(r.yb[k]); s += y[2 * k] + y[2 * k + 1]; }
      s += __shfl_xor(s, 1); s += __shfl_xor(s, 2); s += __shfl_xor(s, 4);
      const float mean = s * (1.f / 64.f); float s2 = 0.f;
#pragma unroll
      for (int k = 0; k < 8; ++k) { y[k] -= mean; s2 += y[k] * y[k]; }
      s2 += __shfl_xor(s2, 1); s2 += __shfl_xor(s2, 2); s2 += __shfl_xor(s2, 4);
      const float rstd = rsqrtf(s2 * (1.f / 64.f) + 64e-5f);
      const float bon = ((r.bp0[0] + r.bp0[1]) + (r.bp0[2] + r.bp0[3])) + ((r.bp1[0] + r.bp1[1]) + (r.bp1[2] + r.bp1[3]));
      u32x4 w;
#pragma unroll
      for (int k = 0; k < 4; ++k) {
        float res[2];
#pragma unroll
        for (int hh = 0; hh < 2; ++hh) {
          const int col = 8 * ch + 2 * k + hh;
          const float x0 = hh ? bfhi(r.v0[k]) : bflo(r.v0[k]), xm = hh ? bfhi(r.vm[k]) : bflo(r.vm[k]), xp = hh ? bfhi(r.vq[k]) : bflo(r.vq[k]);
          const float vs = x0 + mu[1024 + col] * (xm - x0) + mu[1792 + 1024 + col] * (xp - x0);
          const float gn = y[2 * k + hh] * rstd * lng[col] + lnb[col];
          const float gv = hh ? bfhi(r.gg[k]) : bflo(r.gg[k]);
          res[hh] = (gn + bon * vs) * silu_f(gv);
        }
        w[k] = pk2(res[0], res[1]);
      }
      if (!dry) *(u32x4*)(P + (size_t)tok * PC + B_G + 8 * ch) = w;
    };
    for (int i = gt; i < TC * 64; i += 2 * GT) {
      const int i2 = i + GT; const bool two = i2 < TC * 64;
      LB ra, rb;
      loadB(i, ra); if (two) loadB(i2, rb);
      doB(i, ra); if (two) doB(i2, rb);
    }
  }
}

DEVI void phase_ygemm(const Params& p, int l, int c, char* lds) {
  unsigned char* ws = p.ws;
  LAUNDER_S(l); LAUNDER_S(c); LAUNDER_GP(ws);
  int tid_ = threadIdx.x; LAUNDER_V(tid_);
  const int lane = tid_ & 63, wave = tid_ >> 6, wm = wave >> 1, wn = wave & 1, q = lane & 15, g = lane >> 4;
  const bf16_t* HB = (const bf16_t*)(ws + WS_HB) + (size_t)c * TC * DM;
  const bf16_t* P = (const bf16_t*)(ws + WS_P);
  const bf16_t* WG = (const bf16_t*)(ws + WS_WGATE);
  const bf16_t* WB = (const bf16_t*)(ws + WS_WBR);
  bf16_t* Y = (bf16_t*)(ws + WS_AT);
  const float* bg = p.in[23] + (size_t)l * 5120;
  for (int it = blockIdx.x; it < 512; it += gridDim.x) {
    const int xcd = it & 7, loc = it >> 3;
    const int np = loc & 7, mp = 8 * (loc >> 3) + xcd;
    const int m0 = mp * 128, n0 = np * 128;
    f32x4 y[4][4]; zero_acc(y);
#pragma unroll 1
    for (int br = 0; br < 5; ++br) {
      const int gcol = br == 0 ? A_G : br == 1 ? B_G : br == 2 ? C_G : br == 3 ? D_G : M_G;
      const int kw = br == 4 ? 256 : 512;
      f32x4 acc[4][4]; zero_acc(acc);
      gemm_core<true>(P + (size_t)m0 * PC + gcol, PC, WB + (size_t)n0 * 2304 + 512 * br, 2304, kw / 64, acc, lds);
      unsigned pp[4][4][2];
#pragma unroll
      for (int j = 0; j < 4; ++j)
#pragma unroll
        for (int i = 0; i < 4; ++i) { pp[j][i][0] = pk2(acc[j][i][0], acc[j][i][1]); pp[j][i][1] = pk2(acc[j][i][2], acc[j][i][3]); }
      zero_acc(acc);
      gemm_core<false>(HB + (size_t)m0 * DM, DM, WG + (size_t)(br * 1024 + n0) * DM, DM, 16, acc, lds);
#pragma unroll
      for (int j = 0; j < 4; ++j) {
        const f32x4 bv = *(const f32x4*)(bg + br * 1024 + n0 + wn * 64 + 16 * j + 4 * g);
#pragma unroll
        for (int i = 0; i < 4; ++i) {
          y[j][i][0] += sigmoid_f(acc[j][i][0] + bv[0]) * bflo(pp[j][i][0]);
          y[j][i][1] += sigmoid_f(acc[j][i][1] + bv[1]) * bfhi(pp[j][i][0]);
          y[j][i][2] += sigmoid_f(acc[j][i][2] + bv[2]) * bflo(pp[j][i][1]);
          y[j][i][3] += sigmoid_f(acc[j][i][3] + bv[3]) * bfhi(pp[j][i][1]);
        }
      }
    }
#pragma unroll
    for (int i = 0; i < 4; ++i) {
      bf16_t* rowp = Y + (size_t)(m0 + wm * 64 + 16 * i + q) * DM + n0 + wn * 64 + 4 * g;
#pragma unroll
      for (int j = 0; j < 4; ++j) { u32x2 w; w.x = pk2(y[j][i][0], y[j][i][1]); w.y = pk2(y[j][i][2], y[j][i][3]); *(u32x2*)(rowp + 16 * j) = w; }
    }
  }
}

DEVI void phase_outgemm(const Params& p, int l, int c, char* lds) {
  unsigned char* ws = p.ws;
  LAUNDER_S(l); LAUNDER_S(c); LAUNDER_GP(ws);
  int tid = threadIdx.x; LAUNDER_V(tid);
  const int lane = tid & 63, wave = tid >> 6, wm = wave >> 1, wn = wave & 1, q = lane & 15, g = lane >> 4;
  const bf16_t* Y = (const bf16_t*)(ws + WS_AT);
  const bf16_t* WO = (const bf16_t*)(ws + WS_WOUT) + (size_t)l * 1024 * 1024;
  float* H = p.out + (size_t)c * TC * DM;
  f32x2* ST = (f32x2*)(ws + WS_STATS) + (size_t)c * TC * 16;
  const float alpha = 1.41421356237309515f;
  for (int it = blockIdx.x; it < 512; it += gridDim.x) {
    const int np = it & 7, mp = it >> 3;
    const int m0 = mp * 128, n0 = np * 128;
    f32x4 acc[4][4]; zero_acc(acc);
    gemm_core(Y + (size_t)m0 * DM, DM, WO + (size_t)n0 * DM, DM, 16, acc, lds);
#pragma unroll
    for (int i = 0; i < 4; ++i) {
      const int row = m0 + wm * 64 + 16 * i + q;
      float* hp = H + (size_t)row * DM + n0 + wn * 64 + 4 * g;
      float s = 0.f;
#pragma unroll
      for (int j = 0; j < 4; ++j) { const f32x4 hv = *(const f32x4*)(hp + 16 * j); acc[j][i] = acc[j][i] + alpha * hv; s += (acc[j][i][0] + acc[j][i][1]) + (acc[j][i][2] + acc[j][i][3]); }
      s += __shfl_xor(s, 16); s += __shfl_xor(s, 32);
      const float mw = s * (1.f / 64.f);
      float m2 = 0.f;
#pragma unroll
      for (int j = 0; j < 4; ++j) { const f32x4 d = acc[j][i] - mw; m2 += (d[0] * d[0] + d[1] * d[1]) + (d[2] * d[2] + d[3] * d[3]); *(f32x4*)(hp + 16 * j) = acc[j][i]; }
      m2 += __shfl_xor(m2, 16); m2 += __shfl_xor(m2, 32);
      if (g == 0) ST[(size_t)row * 16 + np * 2 + wn] = (f32x2){mw, m2};
    }
  }
}

DEVI void ln_apply_rows(const Params& p, int l, int c, int first, int stride, int last) {
  unsigned char* ws = p.ws;
  l = __builtin_amdgcn_readfirstlane(l); c = __builtin_amdgcn_readfirstlane(c);
  LAUNDER_S(l); LAUNDER_S(c); LAUNDER_GP(ws);
  int tid = threadIdx.x; LAUNDER_V(tid);
  const int lane = tid & 63, wave = tid >> 6;
  float* H = p.out + (size_t)c * TC * DM;
  bf16_t* HB = (bf16_t*)(ws + WS_HB) + (size_t)c * TC * DM;
  const f32x2* ST = (const f32x2*)(ws + WS_STATS) + (size_t)c * TC * 16;
  const float* lg = p.in[25] + (size_t)l * DM; const float* lb = p.in[26] + (size_t)l * DM;
  for (int it = first; it < last && it < TC / 4; it += stride == (1 << 30) ? 1 : stride) {
    const int row = it * 4 + wave;
    const f32x2 st = ST[(size_t)row * 16 + (lane & 15)];
    float ms = st.x;
    ms += __shfl_xor(ms, 1); ms += __shfl_xor(ms, 2); ms += __shfl_xor(ms, 4); ms += __shfl_xor(ms, 8);
    const float mean = ms * (1.f / 16.f);
    const float dm = st.x - mean;
    float m2 = st.y + 64.f * dm * dm;
    m2 += __shfl_xor(m2, 1); m2 += __shfl_xor(m2, 2); m2 += __shfl_xor(m2, 4); m2 += __shfl_xor(m2, 8);
    const float rstd = rsqrtf(m2 * (1.f / DM) + 1e-5f);
    f32x4* hp = (f32x4*)(H + (size_t)row * DM);
    u32x2* hbp = (u32x2*)(HB + (size_t)row * DM);
#pragma unroll
    for (int j = 0; j < 4; ++j) {
      const f32x4 x = hp[lane + 64 * j];
      const f32x4 gv = ((const f32x4*)lg)[lane + 64 * j], bv = ((const f32x4*)lb)[lane + 64 * j];
      const f32x4 o = (x - mean) * rstd * gv + bv;
      hp[lane + 64 * j] = o;
      u32x2 w; w.x = pk2(o[0], o[1]); w.y = pk2(o[2], o[3]);
      hbp[lane + 64 * j] = w;
    }
  }
}

#define XB_TMO      128
#define XB_XCNT(j)  (256  + 64 * (j))
#define XB_XSUB(j)  (1280 + 64 * (j))
#define XB_XGEN(j)  (2304 + 64 * (j))
#define XB_TOP      3328
#define XB_TOPGEN   3392
#define XCD_BAR_WORDS 3456
#define XB_SPIN_CAP (1u << 22)
DEVI unsigned xb_ld(unsigned* p) { return __hip_atomic_load(p, __ATOMIC_RELAXED, __HIP_MEMORY_SCOPE_AGENT); }
DEVI unsigned xb_add(unsigned* p, unsigned v) { return __hip_atomic_fetch_add(p, v, __ATOMIC_RELAXED, __HIP_MEMORY_SCOPE_AGENT); }
DEVI unsigned xb_xcc_id() { return (unsigned)__builtin_amdgcn_s_getreg((3 << 11) | 20) & 0xFu; }
#define XB_SPIN(cond, bar) do { unsigned _sp = 0; while (cond) { __builtin_amdgcn_s_sleep(1); \
    if ((++_sp & 255u) == 0u) { if (xb_ld(&(bar)[XB_TMO])) break; if (_sp > XB_SPIN_CAP) { atomicAdd(&(bar)[XB_TMO], 1u); break; } } } } while (0)
struct XcdBarrier { unsigned* bar; unsigned x; volatile LAS unsigned* st; };
DEVI XcdBarrier xcd_barrier_post(unsigned* bar, volatile LAS unsigned* st) {
  XcdBarrier b; b.bar = bar; b.x = xb_xcc_id(); b.st = st;
  if (threadIdx.x == 0) (void)xb_add(&bar[XB_XCNT(b.x)], 1u);
  return b;
}
DEVI void xcd_barrier_complete(unsigned* bar, unsigned x, unsigned& nloc, unsigned& nx) {
  const unsigned G = gridDim.x * gridDim.y * gridDim.z;
  unsigned sum, cnt, mine, sp = 0u;
  for (;;) {
    sum = 0u; cnt = 0u; mine = 0u;
#pragma unroll
    for (unsigned j = 0; j < 16; ++j) { const unsigned c = xb_ld(&bar[XB_XCNT(j)]); sum += c; cnt += (c > 0u) ? 1u : 0u; mine = (j == x) ? c : mine; }
    if (sum == G) break;
    __builtin_amdgcn_s_sleep(1);
    if ((++sp & 255u) == 0u) { if (xb_ld(&bar[XB_TMO])) break; if (sp > XB_SPIN_CAP) { atomicAdd(&bar[XB_TMO], 1u); break; } }
  }
  nloc = mine > 0u ? mine : 1u; nx = cnt > 0u ? cnt : 1u;
}
DEVI void xcd_barrier1(const XcdBarrier& b) {
  asm volatile("s_waitcnt vmcnt(0)" ::: "memory");
  __syncthreads();
  if (threadIdx.x == 0) {
    unsigned* bar = b.bar;
    __builtin_amdgcn_s_waitcnt(0);
    unsigned nloc = b.st[0], nx = b.st[1];
    if (nloc == 0u) { xcd_barrier_complete(bar, b.x, nloc, nx); b.st[0] = nloc; b.st[1] = nx; }
    const unsigned old = xb_add(&bar[XB_XSUB(b.x)], 1u);
    const unsigned gen = old / nloc;
    if (old + 1u == (gen + 1u) * nloc) {
      __builtin_amdgcn_fence(__ATOMIC_RELEASE, "agent");
      asm volatile("s_waitcnt vmcnt(0)" ::: "memory");
      const unsigned og = xb_add(&bar[XB_TOP], 1u);
      const unsigned tg = og / nx;
      if (og + 1u != (tg + 1u) * nx) XB_SPIN(xb_ld(&bar[XB_TOP]) < (tg + 1u) * nx, bar);
      xb_add(&bar[XB_XGEN(b.x)], 1u);
      __builtin_amdgcn_fence(__ATOMIC_ACQUIRE, "agent");
      asm volatile("s_waitcnt vmcnt(0)" ::: "memory");
    } else {
      XB_SPIN(xb_ld(&bar[XB_XGEN(b.x)]) == gen, bar);
      __builtin_amdgcn_fence(__ATOMIC_ACQUIRE, "agent");
      asm volatile("s_waitcnt vmcnt(0)" ::: "memory");
    }
  }
  __syncthreads();
}

DEVI void xcd_barrier(const XcdBarrier& b) {
  xcd_barrier1(b);
#if DUP_PHASE == 9
  xcd_barrier1(b);
#endif
}

constexpr int LDS_BYTES = LDS_BYTES_C;

#if !MEGA
template <int PH>
__global__ void __launch_bounds__(256, 2) k_phase(Params p, int l, int c) {
  __shared__ __attribute__((aligned(16))) char lds[LDS_BYTES];
  if (PH == 0) phase_setup(p, lds);
  if (PH == 1) phase_pm(p, l, c, lds);
  if (PH == 3) phase_finalize(p, l, c, lds);
  if (PH == 4) phase_ygemm(p, l, c, lds);
  if (PH == 5) phase_outgemm(p, l, c, lds);
  if (PH == 6) convert_layer_weights(p, l, blockIdx.x, gridDim.x, (float*)lds);
}
#endif

__global__ void __launch_bounds__(256, 2) k_mega(Params p) {
  __shared__ __attribute__((aligned(16))) char lds[LDS_BYTES];
  cg::grid_group grid = cg::this_grid();
  volatile LAS unsigned* st = (volatile LAS unsigned*)(lds + LDS_CTRL);
  if (threadIdx.x == 0) { st[0] = 0u; st[1] = 0u; }
  __syncthreads();
  XcdBarrier bar = xcd_barrier_post((unsigned*)(p.ws + WS_CTL) + 4096, st);
  if (threadIdx.x == 0) {
    const unsigned hw = (unsigned)__builtin_amdgcn_s_getreg((31 << 11) | 4);
    const unsigned key = (bar.x << 8) | ((hw >> 8) & 0xffu);
    const unsigned slot = atomicAdd((unsigned*)(p.ws + WS_CTL) + 8192 + key, 1u);
    *(volatile LAS int*)(lds + LDS_CTRL + 20) = (int)(slot & 1u);
    *(volatile LAS int*)(lds + LDS_CTRL + 24) = (int)key;
  }
  __syncthreads();
  phase_setup(p, lds);
#if DUP_PHASE == 10
  xcd_barrier(bar);
  phase_setup(p, lds);
#endif
  xcd_barrier(bar);
  if (p.out == nullptr) grid.sync();
#pragma unroll 1
  for (int l = 0; l < 2; ++l) {
#pragma unroll 1
    for (int c = 0; c < NCHUNK; ++c) {
      phase_pm(p, l, c, lds);
      xcd_barrier(bar);
#if DUP_PHASE == 3
      { int dry = 1; LAUNDER_S(dry); phase_finalize(p, l, c, lds, dry); xcd_barrier(bar); }
#endif
      phase_finalize(p, l, c, lds);
      xcd_barrier(bar);
      {
        constexpr int NREP4 = (DUP_PHASE == 4) ? 2 : 1;
#pragma unroll 1
        for (int rep = 0; rep < NREP4; ++rep) { phase_ygemm(p, l, c, lds); xcd_barrier(bar); }
      }
      phase_outgemm(p, l, c, lds);
      if (l == 0 && c == NCHUNK - 1) convert_layer_weights(p, 1, blockIdx.x, gridDim.x, (float*)lds);
      xcd_barrier(bar);
    }
  }
  ln_apply_rows(p, 1, NCHUNK - 1, (int)blockIdx.x, (int)gridDim.x);
}

extern "C" void kernel_launch(void* const* d_in, const int* in_sizes, int n_in, void* d_out, int out_size, void* d_ws, size_t ws_size, hipStream_t stream) {
  Params p{};
  for (int i = 0; i < 27; ++i) p.in[i] = (const float*)d_in[i];
  p.out = (float*)d_out; p.ws = (unsigned char*)d_ws;
  (void)hipMemsetAsync((char*)d_ws + WS_CTL, 0, 131072, stream);
#if MEGA
  static int grid_blocks = 0;
  if (!grid_blocks) {
    int dev = 0, cus = 0, per_cu = 0;
    (void)hipGetDevice(&dev);
    (void)hipDeviceGetAttribute(&cus, hipDeviceAttributeMultiprocessorCount, dev);
    (void)hipOccupancyMaxActiveBlocksPerMultiprocessor(&per_cu, k_mega, 256, 0);
    if (per_cu > 2) per_cu = 2;
    if (per_cu < 1) per_cu = 1;
    grid_blocks = cus * per_cu;
  }
  void* args[] = {&p};
  hipError_t e = hipLaunchCooperativeKernel((void*)k_mega, dim3(grid_blocks), dim3(256), args, 0, stream);
  if (e != hipSuccess) fprintf(stderr, "cooperative launch failed: %s (grid %d)\n", hipGetErrorString(e), grid_blocks);
#else
  const int G = 512;
  hipLaunchKernelGGL(k_phase<0>, dim3(G), dim3(256), 0, stream, p, 0, 0);
  for (int l = 0; l < 2; ++l) {
    if (l == 1) hipLaunchKernelGGL(k_phase<6>, dim3(G), dim3(256), 0, stream, p, 1, 0);
    for (int c = 0; c < NCHUNK; ++c) {
      hipLaunchKernelGGL(k_phase<1>, dim3(G), dim3(256), 0, stream, p, l, c);
      hipLaunchKernelGGL(k_phase<2>, dim3(G), dim3(256), 0, stream, p, l, c);
      hipLaunchKernelGGL(k_phase<3>, dim3(G), dim3(256), 0, stream, p, l, c);
      hipLaunchKernelGGL(k_phase<4>, dim3(G), dim3(256), 0, stream, p, l, c);
      hipLaunchKernelGGL(k_phase<5>, dim3(G), dim3(256), 0, stream, p, l, c);
    }
  }
#endif
}
```
